# Optimizing an MI355X kernel written in HIP

```python
import math
import jax, jax.numpy as jnp
from jax import lax
import numpy as np

D_MODEL = 1024
BATCH = 8
SEQ = 8192
DEPTH = 1
DEC_BATCH = 4
DEC_SEQ = 8192
PAST_LEN = 128

N_RET_HEADS = 8
RET_QK_DIM = D_MODEL // 16
RET_V_DIM = D_MODEL // N_RET_HEADS
RET_QK = N_RET_HEADS * RET_QK_DIM
RET_V = N_RET_HEADS * RET_V_DIM
CHUNK = 128
ROPE_BASE = 10000.0
POOL_WINDOWS = (2, 4, 8, 16)
N_POOL_GROUPS = 4
POOL_WIDTH = D_MODEL // 2
POOL_GROUP_IN = POOL_WIDTH // N_POOL_GROUPS
POOL_GROUP_OUT = D_MODEL // N_POOL_GROUPS
D_FF = 128 * ((8 * D_MODEL // 3 + 127) // 128)
CONV_WIDTH = 3
N_MOD = 6
EPS = 1e-6
IN_WIDTH = 2 * RET_QK + 2 * RET_V + POOL_WIDTH + 2 * D_MODEL
IN_SPLITS = (RET_QK, 2 * RET_QK, 2 * RET_QK + RET_V, 2 * RET_QK + 2 * RET_V,
             2 * RET_QK + 2 * RET_V + POOL_WIDTH, 2 * RET_QK + 2 * RET_V + POOL_WIDTH + D_MODEL)

kernel_name = "gated_retention_pool_encoder"


def _rmsnorm(x, g):
    xf = x.astype(jnp.float32)
    return xf * lax.rsqrt(jnp.mean(xf * xf, axis=-1, keepdims=True) + EPS) * g.astype(jnp.float32)


def _rope_tables(s):
    half = RET_QK_DIM // 2
    inv_freq = ROPE_BASE ** (-jnp.arange(half, dtype=jnp.float32) / half)
    ang = jnp.arange(s, dtype=jnp.float32)[:, None] * inv_freq[None, :]
    return jnp.cos(ang)[None, :, None, :], jnp.sin(ang)[None, :, None, :]


def _rotary(t, cos, sin):
    t1, t2 = jnp.split(t, 2, axis=-1)
    return jnp.concatenate([t1 * cos - t2 * sin, t1 * sin + t2 * cos], axis=-1)


def _retention_one_direction(q, k, v, log_g, strict):
    b, s, h, dk = q.shape
    dv = v.shape[-1]
    n = s // CHUNK

    def chunks(t):
        return t.reshape(b, n, CHUNK, h, t.shape[-1]).transpose(1, 0, 3, 2, 4)

    idx = jnp.arange(CHUNK, dtype=jnp.float32)
    diff = idx[:, None] - idx[None, :]
    allowed = diff >= (1.0 if strict else 0.0)
    decay_in = jnp.where(allowed[None], jnp.exp(jnp.where(allowed, diff, 0.0)[None] * log_g[:, None, None]), 0.0)
    decay_q = jnp.exp((idx + 1.0)[None, :] * log_g[:, None])[None, :, :, None]
    decay_k = jnp.exp((CHUNK - 1.0 - idx)[None, :] * log_g[:, None])[None, :, :, None]
    decay_chunk = jnp.exp(CHUNK * log_g)[None, :, None, None]

    def step(state, qkv):
        qc, kc, vc = qkv
        scores = jnp.einsum('bhqd,bhkd->bhqk', qc, kc) * decay_in
        inner = jnp.einsum('bhqk,bhke->bhqe', scores, vc)
        cross = jnp.einsum('bhqd,bhde->bhqe', qc * decay_q, state)
        new_state = decay_chunk * state + jnp.einsum('bhkd,bhke->bhde', kc * decay_k, vc)
        return new_state, inner + cross

    state0 = jnp.zeros((b, h, dk, dv), jnp.float32)
    _, out = lax.scan(step, state0, (chunks(q), chunks(k), chunks(v)))
    return out.transpose(1, 0, 3, 2, 4).reshape(b, s, h, dv)


def _multiscale_pool(p):
    s = p.shape[1]
    pos = jnp.arange(s)
    outs = []
    for gi, w in enumerate(POOL_WINDOWS):
        pg = p[..., gi * POOL_GROUP_IN:(gi + 1) * POOL_GROUP_IN]
        cs = jnp.pad(jnp.cumsum(pg, axis=1), ((0, 0), (1, 0), (0, 0)))
        lo = jnp.clip(pos - w // 2, 0, s)
        hi = jnp.clip(pos + w // 2, 0, s)
        cnt = (hi - lo).astype(jnp.float32)
        mean = (jnp.take(cs, hi, axis=1) - jnp.take(cs, lo, axis=1)) / cnt[None, :, None]
        outs.append(mean - pg)
    return jnp.stack(outs, axis=2)


def _dwconv_centred(u, w, bias):
    up = jnp.pad(u, ((0, 0), (1, 1), (0, 0)))
    return up[:, :-2] * w[0] + up[:, 1:-1] * w[1] + up[:, 2:] * w[2] + bias


def _layer(x, c, w_ada, b_ada, g_mix, w_in, ret_decay_f, ret_decay_b, ret_gn_gain,
           w_pool_grp, pool_scale, w_out, g_ffn, w_up, conv_w, conv_b, w_down):
    dt = x.dtype
    b, s, _ = x.shape
    mod = jnp.dot(jax.nn.silu(c), w_ada) + b_ada
    shift1, scale1, gate1, shift2, scale2, gate2 = [m[:, None, :] for m in jnp.split(mod, N_MOD, axis=-1)]

    h = (_rmsnorm(x, g_mix) * (1.0 + scale1) + shift1).astype(dt)
    proj = jnp.einsum('bsd,de->bse', h, w_in)
    q, k, v, g_sw, p, gate_a, gate_b = jnp.split(proj, IN_SPLITS, axis=-1)

    cos, sin = _rope_tables(s)
    qh = _rotary(q.astype(jnp.float32).reshape(b, s, N_RET_HEADS, RET_QK_DIM), cos, sin)
    kh = _rotary(k.astype(jnp.float32).reshape(b, s, N_RET_HEADS, RET_QK_DIM), cos, sin) * (RET_QK_DIM ** -0.5)
    vh = v.astype(jnp.float32).reshape(b, s, N_RET_HEADS, RET_V_DIM)
    log_g_f = jax.nn.log_sigmoid(ret_decay_f.astype(jnp.float32))
    log_g_b = jax.nn.log_sigmoid(ret_decay_b.astype(jnp.float32))
    ret_f = _retention_one_direction(qh, kh, vh, log_g_f, strict=False)
    ret_b = _retention_one_direction(qh[:, ::-1], kh[:, ::-1], vh[:, ::-1], log_g_b, strict=True)[:, ::-1]
    ret = ret_f + ret_b
    mu = jnp.mean(ret, axis=-1, keepdims=True)
    var = jnp.mean(jnp.square(ret - mu), axis=-1, keepdims=True)
    ret = ((ret - mu) * lax.rsqrt(var + EPS)).reshape(b, s, RET_V) * ret_gn_gain.astype(jnp.float32)
    branch_a = jax.nn.silu(g_sw.astype(jnp.float32)) * ret

    pooled = _multiscale_pool(p.astype(jnp.float32))
    branch_b = jnp.einsum('bsgi,gio->bsgo', pooled, w_pool_grp.astype(jnp.float32)).reshape(b, s, D_MODEL)
    branch_b = branch_b * pool_scale.astype(jnp.float32)

    merged = jax.nn.sigmoid(gate_a.astype(jnp.float32)) * branch_a + jax.nn.sigmoid(gate_b.astype(jnp.float32)) * branch_b
    mix_out = jnp.einsum('bsd,de->bse', merged.astype(dt), w_out)
    x = x + gate1 * mix_out

    h2 = (_rmsnorm(x, g_ffn) * (1.0 + scale2) + shift2).astype(dt)
    up = jnp.einsum('bsd,df->bsf', h2, w_up)
    up = _dwconv_centred(up, conv_w, conv_b)
    act, lin = jnp.split(up, 2, axis=-1)
    ffn = jnp.einsum('bsf,fd->bsd', jax.nn.gelu(act) * lin, w_down)
    return x + gate2 * ffn


def _encoder(x, c, w_ada, b_ada, g_mix, w_in, ret_decay_f, ret_decay_b, ret_gn_gain,
             w_pool_grp, pool_scale, w_out, g_ffn, w_up, conv_w, conv_b, w_down, g_final):
    for l in range(DEPTH):
        x = _layer(x, c, w_ada[l], b_ada[l], g_mix[l], w_in[l], ret_decay_f[l], ret_decay_b[l],
                   ret_gn_gain[l], w_pool_grp[l], pool_scale[l], w_out[l], g_ffn[l], w_up[l],
                   conv_w[l], conv_b[l], w_down[l])
    return _rmsnorm(x, g_final).astype(x.dtype)


def setup_inputs(seed: int = 0) -> dict:
    key = jax.random.key(seed)
    ks = jax.random.split(key, 24)
    f32 = jnp.float32
    nrm = lambda k, shape, scale: jax.random.normal(k, shape, f32) * scale
    base_logit = jnp.log(2.0 ** (5.0 + jnp.arange(N_RET_HEADS, dtype=f32)) - 1.0)
    return {
        "x_prompt": nrm(ks[0], (BATCH, SEQ, D_MODEL), 1.0),
        "x_sample": nrm(ks[1], (DEC_BATCH, DEC_SEQ, D_MODEL), 1.0),
        "c_prompt": nrm(ks[2], (BATCH, D_MODEL), 1.0),
        "c_sample": nrm(ks[3], (DEC_BATCH, D_MODEL), 1.0),
        "w_ada": nrm(ks[4], (DEPTH, D_MODEL, N_MOD * D_MODEL), D_MODEL ** -0.5),
        "b_ada": nrm(ks[5], (DEPTH, N_MOD * D_MODEL), 0.02),
        "g_mix": 1.0 + nrm(ks[6], (DEPTH, D_MODEL), 0.05),
        "w_in": nrm(ks[7], (DEPTH, D_MODEL, IN_WIDTH), D_MODEL ** -0.5),
        "ret_decay_f": base_logit[None, :] + nrm(ks[8], (DEPTH, N_RET_HEADS), 0.1),
        "ret_decay_b": base_logit[None, :] + nrm(ks[9], (DEPTH, N_RET_HEADS), 0.1),
        "ret_gn_gain": 1.0 + nrm(ks[10], (DEPTH, RET_V), 0.05),
        "w_pool_grp": nrm(ks[11], (DEPTH, N_POOL_GROUPS, POOL_GROUP_IN, POOL_GROUP_OUT), POOL_GROUP_IN ** -0.5),
        "pool_scale": 1.0 + nrm(ks[12], (DEPTH, D_MODEL), 0.1),
        "w_out": nrm(ks[13], (DEPTH, D_MODEL, D_MODEL), D_MODEL ** -0.5),
        "g_ffn": 1.0 + nrm(ks[14], (DEPTH, D_MODEL), 0.05),
        "w_up": nrm(ks[15], (DEPTH, D_MODEL, 2 * D_FF), D_MODEL ** -0.5),
        "conv_w": nrm(ks[16], (DEPTH, CONV_WIDTH, 2 * D_FF), CONV_WIDTH ** -0.5),
        "conv_b": nrm(ks[17], (DEPTH, 2 * D_FF), 0.02),
        "w_down": nrm(ks[18], (DEPTH, D_FF, D_MODEL), D_FF ** -0.5),
        "g_final": 1.0 + nrm(ks[19], (D_MODEL,), 0.05),
    }


def reference(x_prompt, x_sample, c_prompt, c_sample, w_ada, b_ada, g_mix, w_in, ret_decay_f,
              ret_decay_b, ret_gn_gain, w_pool_grp, pool_scale, w_out, g_ffn, w_up, conv_w, conv_b,
              w_down, g_final):
    y_prompt = _encoder(x_prompt, c_prompt, w_ada, b_ada, g_mix, w_in, ret_decay_f, ret_decay_b,
                        ret_gn_gain, w_pool_grp, pool_scale, w_out, g_ffn, w_up, conv_w, conv_b,
                        w_down, g_final)
    y_sample = _encoder(x_sample, c_sample, w_ada, b_ada, g_mix, w_in, ret_decay_f, ret_decay_b,
                        ret_gn_gain, w_pool_grp, pool_scale, w_out, g_ffn, w_up, conv_w, conv_b,
                        w_down, g_final)
    return (y_prompt, y_sample)
```

```cpp
#include <hip/hip_runtime.h>
#include <cstdio>
#include <cstdint>
namespace pg8 {
#define PG8_LAS __attribute__((address_space(3)))
typedef unsigned short bf16_t;
typedef short bf16x8 __attribute__((ext_vector_type(8)));
typedef float f32x4 __attribute__((ext_vector_type(4)));
typedef unsigned u32x4 __attribute__((ext_vector_type(4)));
constexpr int BM = 256, BK = 64, HALF = 128, HTB = HALF * BK * 2  , STAGE_BYTES = 8 * HTB, NXCD = 8, WGM = 8;

__host__ __device__ __forceinline__ int lds_byte(int r, int c) { const int st = (r >> 4) * 2 + (c >> 5), rr = r & 15, cc = c & 31, ob = rr * 64 + cc * 2; return st * 1024 + (ob ^ (((ob >> 9) & 1) << 5)); }
__host__ __device__ __forceinline__ void stage_rc(int b, int& R, int& C) { const int st = b / 1024, sb = b % 1024, swz = sb ^ (((sb >> 9) & 1) << 5); R = (st >> 1) * 16 + swz / 64; C = (st & 1) * 32 + (swz % 64) / 2; }
__host__ __device__ __forceinline__ int perm32(int rho) { const int n = rho >> 4, i = rho & 15; return 8 * (i >> 2) + 4 * n + (i & 3); }

struct Unit { int pm, pn; };
struct Gemm { const bf16_t* A; const bf16_t* Bt; int M, N, K; };

struct StaticOrder {
    int nM, nN, nwg, G, c;
    __host__ __device__ void init(int M, int N, int G_, int c_) { nM = M / BM; nN = N / BM; nwg = nM * nN; G = G_; c = c_; }
    __host__ __device__ bool next(int i, Unit& u) const {
        const long L = (long)i * G + c; if (L >= nwg) return false;
        int wgid = (int)L; { const int q = nwg / NXCD, r = nwg % NXCD, xcd = wgid % NXCD, off = wgid / NXCD; wgid = (xcd < r ? xcd * (q + 1) : r * (q + 1) + (xcd - r) * q) + off; }
        const int nig = WGM * nN, gid = wgid / nig, fm = gid * WGM, gsz = (nM - fm) < WGM ? (nM - fm) : WGM;
        u.pm = fm + ((wgid % nig) % gsz); u.pn = (wgid % nig) / gsz; return true;
    }
    __device__ __forceinline__ void a_ready(const Unit&) const {}
    __device__ __forceinline__ void done(const Unit&) const {}
};
__device__ __forceinline__ unsigned cvt_pk_bf16(float lo, float hi) { unsigned r; asm volatile("v_cvt_pk_bf16_f32 %0, %1, %2" : "=v"(r) : "v"(lo), "v"(hi)); return r; }
typedef float f32x2 __attribute__((ext_vector_type(2)));
struct EpiProj {
    static constexpr bool PERM = true, AFTER_DRAIN = false;
    bf16_t* O; int ldc; const float* cosT; const float* sinT;
    __device__ __forceinline__ void operator()(const f32x4 (&acc)[2][2][4][2], const Unit& u, int wr, int wc, int fr, int fq) const {
        const int row0 = u.pm * BM + wr * 64 + fr, col0 = u.pn * BM + wc * 32 + 8 * fq;
        const bool rot = u.pn < 4; const float sc = (u.pn >= 2 && u.pn < 4) ? 0.125f : 1.0f;
        const int fi0 = ((wc & 1) * 32 + 8 * fq) >> 1;
#pragma unroll
        for (int ai = 0; ai < 2; ++ai)
#pragma unroll
            for (int m = 0; m < 4; ++m) { const int row = row0 + ai * HALF + m * 16; bf16_t* rowp = O + (size_t)row * ldc + col0;
                f32x4 c4 = (f32x4){1.f, 1.f, 1.f, 1.f}, s4 = (f32x4){0.f, 0.f, 0.f, 0.f};
                if (rot) { const int pos = row & 8191; c4 = *(const f32x4*)(cosT + pos * 32 + fi0); s4 = *(const f32x4*)(sinT + pos * 32 + fi0); }
#pragma unroll
                for (int bj = 0; bj < 2; ++bj) { f32x4 v0 = acc[ai][bj][m][0], v1 = acc[ai][bj][m][1];
                    if (rot) { const f32x4 o0 = v0 * c4 - v1 * s4, o1 = v0 * s4 + v1 * c4; v0 = o0 * sc; v1 = o1 * sc; }
                    u32x4 w; w.x = cvt_pk_bf16(v0[0], v0[1]); w.y = cvt_pk_bf16(v0[2], v0[3]); w.z = cvt_pk_bf16(v1[0], v1[1]); w.w = cvt_pk_bf16(v1[2], v1[3]);
                    *(u32x4*)(rowp + bj * HALF) = w; } }
    }
};
struct EpiStoreBf16 {
    static constexpr bool PERM = true, AFTER_DRAIN = false;
    bf16_t* O; int ldc;
    __device__ __forceinline__ void operator()(const f32x4 (&acc)[2][2][4][2], const Unit& u, int wr, int wc, int fr, int fq) const {
        const int row0 = u.pm * BM + wr * 64 + fr, col0 = u.pn * BM + wc * 32 + 8 * fq;
#pragma unroll
        for (int ai = 0; ai < 2; ++ai)
#pragma unroll
            for (int m = 0; m < 4; ++m) { bf16_t* rowp = O + (size_t)(row0 + ai * HALF + m * 16) * ldc + col0;
#pragma unroll
                for (int bj = 0; bj < 2; ++bj) { const f32x4 v0 = acc[ai][bj][m][0], v1 = acc[ai][bj][m][1];
                    u32x4 w; w.x = cvt_pk_bf16(v0[0], v0[1]); w.y = cvt_pk_bf16(v0[2], v0[3]); w.z = cvt_pk_bf16(v1[0], v1[1]); w.w = cvt_pk_bf16(v1[2], v1[3]);
                    *(u32x4*)(rowp + bj * HALF) = w; } }
    }
};
struct EpiRes {
    static constexpr bool PERM = false, AFTER_DRAIN = false;
    const float* base; float* out; const float* gate; int b0;
    __device__ __forceinline__ void operator()(const f32x4 (&acc)[2][2][4][2], const Unit& u, int wr, int wc, int fr, int fq) const {
        const int row0 = u.pm * BM + wr * 64 + fr, col0 = u.pn * BM + wc * 32 + 4 * fq;
        const float* gp = gate + (size_t)(b0 + ((u.pm * BM) >> 13)) * 6144 + col0;
        f32x4 gv[2][2];
#pragma unroll
        for (int bj = 0; bj < 2; ++bj)
#pragma unroll
            for (int n = 0; n < 2; ++n) gv[bj][n] = *(const f32x4*)(gp + bj * HALF + n * 16);
#pragma unroll
        for (int ai = 0; ai < 2; ++ai)
#pragma unroll
            for (int m = 0; m < 4; ++m) { const size_t off = (size_t)(row0 + ai * HALF + m * 16) * 1024 + col0;
#pragma unroll
                for (int bj = 0; bj < 2; ++bj)
#pragma unroll
                    for (int n = 0; n < 2; ++n) { const f32x4 bs = *(const f32x4*)(base + off + bj * HALF + n * 16);
                        *(f32x4*)(out + off + bj * HALF + n * 16) = bs + gv[bj][n] * acc[ai][bj][m][n]; }
                asm volatile("" ::: "memory"); }
    }
};
template <class Epi, class Sched, bool ALIGN_EPI = false, bool SP2 = false>
__device__ __forceinline__ void gemm_phase(PG8_LAS unsigned char* lds, const Gemm g, const Sched& S, const Epi& E) {
    int tid_ = threadIdx.x; asm volatile("" : "+v"(tid_));
    const int tid = tid_, wid = __builtin_amdgcn_readfirstlane(tid >> 6), lane = tid & 63, wr = wid >> 2, wc = wid & 3, fr = lane & 15, fq = lane >> 4;
    const int K = g.K, nt = K / BK;
    unsigned voffA[2], voffB[2];
#pragma unroll
    for (int i = 0; i < 2; ++i) { int R, C; stage_rc(tid * 16 + i * 8192, R, C); const int Rb = Epi::PERM ? ((R & ~31) + perm32(R & 31)) : R;
        voffA[i] = (unsigned)(R * K + C) * 2u; voffB[i] = (unsigned)(Rb * K + C) * 2u; }
    const size_t kstep = (size_t)(BK * 2);
    const size_t hstep = (size_t)HALF * K * 2;
    const size_t tstep = 2 * hstep;
    const unsigned ldsw = (unsigned)wid * 1024u;
    const int aoff = lds_byte(wr * 64 + fr, fq * 8), boff = lds_byte(wc * 32 + fr, fq * 8);
#define PG8_SA(b, h) (((b) * 2 + (h)) * HTB)
#define PG8_SB(b, h) ((4 + (b) * 2 + (h)) * HTB)
#define PG8_STAGE(bufoff, gbase, voff) do { _Pragma("unroll") for (int _i = 0; _i < 2; ++_i) \
        __builtin_amdgcn_global_load_lds((const unsigned*)((const char*)(gbase) + (voff)[_i]), (PG8_LAS unsigned*)(lds + (bufoff) + ldsw + _i * 8192), 16, 0, 0); } while (0)
#define PG8_LDA(dst, b, h) do { _Pragma("unroll") for (int m = 0; m < 4; ++m) _Pragma("unroll") for (int k = 0; k < 2; ++k) dst[m][k] = *(const PG8_LAS bf16x8*)(lds + PG8_SA(b, h) + aoff + m * 2048 + k * 1024); } while (0)
#define PG8_LDB(dst, b, h) do { _Pragma("unroll") for (int n = 0; n < 2; ++n) _Pragma("unroll") for (int k = 0; k < 2; ++k) dst[n][k] = *(const PG8_LAS bf16x8*)(lds + PG8_SB(b, h) + boff + n * 2048 + k * 1024); } while (0)
#define PG8_MMA(ai, bj, At, Bt) do { __builtin_amdgcn_s_setprio(1); _Pragma("unroll") for (int m = 0; m < 4; ++m) _Pragma("unroll") for (int n = 0; n < 2; ++n) _Pragma("unroll") for (int k = 0; k < 2; ++k) \
        acc[ai][bj][m][n] = __builtin_amdgcn_mfma_f32_16x16x32_bf16(Bt[n][k], At[m][k], acc[ai][bj][m][n], 0, 0, 0); __builtin_amdgcn_s_setprio(0); } while (0)
#define PG8_WAIT_V(n) asm volatile("s_waitcnt vmcnt(" #n ")" ::: "memory")
#define PG8_WAIT_L(n) asm volatile("s_waitcnt lgkmcnt(" #n ")" ::: "memory")
#define PG8_BAR __builtin_amdgcn_s_barrier()
#define PG8_SCHED __builtin_amdgcn_sched_barrier(0)
    Unit cur, nxt; int ui = 0;
    if (!S.next(0, cur)) return;
    f32x4 acc[2][2][4][2];
#pragma unroll
    for (int a = 0; a < 2; ++a)
#pragma unroll
        for (int b = 0; b < 2; ++b)
#pragma unroll
            for (int m = 0; m < 4; ++m)
#pragma unroll
                for (int n = 0; n < 2; ++n) acc[a][b][m][n] = (f32x4){0.f, 0.f, 0.f, 0.f};
    bf16x8 At[4][2], B0[2][2], B1[2][2];
    const char* cA = (const char*)g.A + (size_t)cur.pm * tstep; const char* cB = (const char*)g.Bt + (size_t)cur.pn * tstep;
    S.a_ready(cur);
    if constexpr (SP2) {
        PG8_STAGE(PG8_SB(0, 0), cB, voffB); PG8_STAGE(PG8_SB(0, 1), cB + hstep, voffB); PG8_STAGE(PG8_SA(0, 0), cA, voffA); PG8_STAGE(PG8_SA(0, 1), cA + hstep, voffA);
        if (wr == 1) PG8_BAR;
        PG8_WAIT_V(2); PG8_BAR;
        PG8_STAGE(PG8_SB(1, 0), cB + kstep, voffB); PG8_STAGE(PG8_SA(1, 0), cA + kstep, voffA); PG8_STAGE(PG8_SB(1, 1), cB + hstep + kstep, voffB);
        PG8_WAIT_V(6); PG8_BAR;
    } else {
        PG8_STAGE(PG8_SB(0, 0), cB, voffB); PG8_STAGE(PG8_SA(0, 0), cA, voffA); PG8_STAGE(PG8_SB(0, 1), cB + hstep, voffB); PG8_STAGE(PG8_SA(0, 1), cA + hstep, voffA);
        if (wr == 1) PG8_BAR;
        PG8_WAIT_V(4); PG8_BAR;
        PG8_STAGE(PG8_SB(1, 0), cB + kstep, voffB); PG8_STAGE(PG8_SA(1, 0), cA + kstep, voffA); PG8_STAGE(PG8_SB(1, 1), cB + hstep + kstep, voffB);
        PG8_WAIT_V(6); PG8_BAR;
    }
    for (;;) {
        const bool has_next = S.next(ui + 1, nxt);
        const char* nA = has_next ? (const char*)g.A + (size_t)nxt.pm * tstep : cA; const char* nB = has_next ? (const char*)g.Bt + (size_t)nxt.pn * tstep : cB;
        for (int t = 0; t < nt; t += 2) {
            const bool last = (t == nt - 2);
            const char* a1 = cA + (size_t)(t + 1) * kstep;
            const char* a2 = last ? nA : cA + (size_t)(t + 2) * kstep; const char* b2 = last ? nB : cB + (size_t)(t + 2) * kstep;
            const char* a3 = a2 + kstep; const char* b3 = b2 + kstep;
            if (last && has_next) S.a_ready(nxt);
            if constexpr (SP2) {
            PG8_LDB(B0, 0, 0); PG8_LDB(B1, 0, 1); PG8_SCHED; PG8_LDA(At, 0, 0); PG8_STAGE(PG8_SA(1, 1), a1 + hstep, voffA);
            PG8_WAIT_V(8); PG8_WAIT_L(0); PG8_BAR; PG8_MMA(0, 0, At, B0); PG8_MMA(0, 1, At, B1); PG8_BAR; PG8_SCHED;
            PG8_LDA(At, 0, 1); PG8_STAGE(PG8_SB(0, 0), b2, voffB); PG8_STAGE(PG8_SB(0, 1), b2 + hstep, voffB); PG8_STAGE(PG8_SA(0, 0), a2, voffA);
            PG8_WAIT_V(8); PG8_WAIT_L(0); PG8_BAR; PG8_MMA(1, 0, At, B0); PG8_MMA(1, 1, At, B1); PG8_BAR; PG8_SCHED;
            PG8_LDB(B0, 1, 0); PG8_LDB(B1, 1, 1); PG8_SCHED; PG8_LDA(At, 1, 0); PG8_STAGE(PG8_SA(0, 1), a2 + hstep, voffA);
            PG8_WAIT_V(8); PG8_WAIT_L(0); PG8_BAR; PG8_MMA(0, 0, At, B0); PG8_MMA(0, 1, At, B1); PG8_BAR; PG8_SCHED;
            PG8_LDA(At, 1, 1); PG8_STAGE(PG8_SB(1, 0), b3, voffB); PG8_STAGE(PG8_SB(1, 1), b3 + hstep, voffB); PG8_STAGE(PG8_SA(1, 0), a3, voffA);
            PG8_WAIT_V(8); PG8_WAIT_L(0); PG8_BAR; PG8_MMA(1, 0, At, B0); PG8_MMA(1, 1, At, B1); PG8_BAR; PG8_SCHED;
            } else {
            PG8_LDB(B0, 0, 0); PG8_SCHED; PG8_LDA(At, 0, 0); PG8_STAGE(PG8_SA(1, 1), a1 + hstep, voffA);
            PG8_WAIT_L(8); PG8_BAR; PG8_WAIT_L(0); PG8_MMA(0, 0, At, B0); PG8_BAR; PG8_SCHED;
            PG8_LDB(B1, 0, 1); PG8_STAGE(PG8_SB(0, 0), b2, voffB);
            PG8_BAR; PG8_WAIT_L(0); PG8_MMA(0, 1, At, B1); PG8_BAR;
            PG8_LDA(At, 0, 1); PG8_STAGE(PG8_SA(0, 0), a2, voffA);
            PG8_BAR; PG8_WAIT_L(0); PG8_MMA(1, 0, At, B0); PG8_BAR; PG8_SCHED;
            PG8_STAGE(PG8_SB(0, 1), b2 + hstep, voffB);
            PG8_WAIT_V(6); PG8_BAR; PG8_MMA(1, 1, At, B1); PG8_BAR;
            PG8_LDB(B0, 1, 0); PG8_SCHED; PG8_LDA(At, 1, 0); PG8_STAGE(PG8_SA(0, 1), a2 + hstep, voffA);
            PG8_WAIT_L(8); PG8_BAR; PG8_WAIT_L(0); PG8_MMA(0, 0, At, B0); PG8_BAR; PG8_SCHED;
            PG8_LDB(B1, 1, 1); PG8_STAGE(PG8_SB(1, 0), b3, voffB);
            PG8_BAR; PG8_WAIT_L(0); PG8_MMA(0, 1, At, B1); PG8_BAR;
            PG8_LDA(At, 1, 1); PG8_STAGE(PG8_SA(1, 0), a3, voffA);
            PG8_BAR; PG8_WAIT_L(0); PG8_MMA(1, 0, At, B0); PG8_BAR; PG8_SCHED;
            PG8_STAGE(PG8_SB(1, 1), b3 + hstep, voffB);
            PG8_WAIT_V(6); PG8_BAR; PG8_MMA(1, 1, At, B1); PG8_BAR;
            }
        }
        if constexpr (ALIGN_EPI) { if (wr == 0) PG8_BAR; }
        if constexpr (!Epi::AFTER_DRAIN) { E(acc, cur, wr, wc, fr, fq); S.done(cur); }
        if (!has_next) break;
#pragma unroll
        for (int a = 0; a < 2; ++a)
#pragma unroll
            for (int b = 0; b < 2; ++b)
#pragma unroll
                for (int m = 0; m < 4; ++m)
#pragma unroll
                    for (int n = 0; n < 2; ++n) acc[a][b][m][n] = (f32x4){0.f, 0.f, 0.f, 0.f};
        cur = nxt; cA = nA; cB = nB; ++ui;
        if constexpr (ALIGN_EPI) { if (wr == 1) PG8_BAR; }
    }
    PG8_WAIT_V(0);
    if constexpr (!ALIGN_EPI) { if (wr == 0) PG8_BAR; }
    PG8_BAR;
    if constexpr (Epi::AFTER_DRAIN) { E.fused(acc, cur, wr, wc, fr, fq, lds, wid, lane); S.done(cur); }
#undef PG8_SA
#undef PG8_SB
#undef PG8_STAGE
#undef PG8_LDA
#undef PG8_LDB
#undef PG8_MMA
#undef PG8_WAIT_V
#undef PG8_WAIT_L
#undef PG8_BAR
#undef PG8_SCHED
}
}
#ifndef PG8_SP2
#define PG8_SP2 true
#endif
#ifndef PG8_ALIGN
#define PG8_ALIGN true
#endif
constexpr int NWAVES = 8;
#ifndef MK_PER_PHASE
#define MK_PER_PHASE 0
#endif

constexpr int D = 1024, SEQ = 8192, NSEQ = 12, SLAB_SEQ = 4, NSLAB = 3, MS = SLAB_SEQ * SEQ;
constexpr int NIN = 5632, NUP = 5632, DFF = 2816;
constexpr int COL_Q = 0, COL_K = 512, COL_V = 1024, COL_GSW = 2048, COL_P = 3072, COL_GA = 3584, COL_GB = 4608;
constexpr int NUNIT = SLAB_SEQ * 64 * 8;
constexpr float EPS = 1e-6f;
constexpr int PH_PER_SLAB = 11, NPHASE = 1 + NSLAB * PH_PER_SLAB;

constexpr size_t MiB = 1u << 20;
constexpr size_t WS_CTL = 0, CTL_ZERO_BYTES = 1 * MiB;
constexpr size_t WS_MOD = 1 * MiB;
constexpr size_t WS_DEC = 1 * MiB + 512 * 1024;
constexpr size_t WS_COS = 2 * MiB, WS_SIN = 3 * MiB;
constexpr size_t WS_WIN = 4 * MiB;
constexpr size_t WS_WOUT = 16 * MiB;
constexpr size_t WS_WUP = 18 * MiB;
constexpr size_t WS_WDOWN = 30 * MiB;
constexpr size_t WS_WPOOL = 36 * MiB;
constexpr size_t WS_H = 64 * MiB;
constexpr size_t WS_MERGED = 128 * MiB;
constexpr size_t WS_PROJ = 192 * MiB;
constexpr size_t WS_G = 544 * MiB;
constexpr size_t WS_LST = 720 * MiB;
constexpr size_t WS_SST = 848 * MiB;
constexpr size_t WS_END = 912 * MiB;
constexpr int CW_TMO = 0, CW_CODE = 1, CW_BAR = 4096;

constexpr int RING_OFF = 0, RING_BYTES = 131072;
constexpr int LDSCTL_OFF = RING_BYTES, MISC_OFF = LDSCTL_OFF + 320;
constexpr int LDS_BYTES = 147456;

#define GAS __attribute__((address_space(1)))
#define LAS __attribute__((address_space(3)))
typedef unsigned short bf16;
typedef unsigned v4u __attribute__((ext_vector_type(4)));
typedef unsigned v2u __attribute__((ext_vector_type(2)));
typedef float f32x4 __attribute__((ext_vector_type(4)));
typedef short bf16x8 __attribute__((ext_vector_type(8)));
typedef short s16x4 __attribute__((ext_vector_type(4)));
typedef GAS unsigned gu32;
#define RLX_AGENT __ATOMIC_RELAXED, __HIP_MEMORY_SCOPE_AGENT
#define LDS_WAIT() asm volatile("s_waitcnt lgkmcnt(0)" ::: "memory")
#define VM_WAIT() asm volatile("s_waitcnt vmcnt(0)" ::: "memory")
__device__ __forceinline__ unsigned f2bf(float f) { unsigned u = __builtin_bit_cast(unsigned, f); return (u + 0x7fffu + ((u >> 16) & 1u)) >> 16; }
__device__ __forceinline__ unsigned pk2(float lo, float hi) { return f2bf(lo) | (f2bf(hi) << 16); }
__device__ __forceinline__ float bf2f(unsigned short b) { return __builtin_bit_cast(float, ((unsigned)b) << 16); }
__device__ __forceinline__ float bflo(unsigned w) { return __builtin_bit_cast(float, w << 16); }
__device__ __forceinline__ float bfhi(unsigned w) { return __builtin_bit_cast(float, w & 0xffff0000u); }
__device__ __forceinline__ float sigmoidf_(float x) { return 1.0f / (1.0f + __expf(-x)); }
__device__ __forceinline__ int launder_v(int x) { asm volatile("" : "+v"(x)); return x; }
__device__ __forceinline__ int launder_s(int x) { asm volatile("" : "+s"(x)); return x; }
#define XB_TMO      128
#define XB_XCNT(j)  (256  + 64 * (j))
#define XB_XSUB(j)  (1280 + 64 * (j))
#define XB_XGEN(j)  (2304 + 64 * (j))
#define XB_TOP      3328
#define XB_TOPGEN   3392
#define XCD_BAR_WORDS 3456
#define XB_SPIN_CAP (1u << 18)

__device__ __forceinline__ unsigned xb_ld(unsigned* p)              { return __hip_atomic_load(p, __ATOMIC_RELAXED, __HIP_MEMORY_SCOPE_AGENT); }
__device__ __forceinline__ unsigned xb_add(unsigned* p, unsigned v) { return __hip_atomic_fetch_add(p, v, __ATOMIC_RELAXED, __HIP_MEMORY_SCOPE_AGENT); }
__device__ __forceinline__ unsigned xb_xcc_id() { return (unsigned)__builtin_amdgcn_s_getreg((3 << 11) | 20) & 0xFu; }
#define XB_SPIN(cond, bar) do { unsigned _sp = 0; while (cond) { __builtin_amdgcn_s_sleep(1); \
    if ((++_sp & 255u) == 0u) { if (xb_ld(&(bar)[XB_TMO])) break; if (_sp > XB_SPIN_CAP) { atomicAdd(&(bar)[XB_TMO], 1u); break; } } } } while (0)

struct XcdBarrier {
    unsigned* bar; unsigned x;
    volatile LAS unsigned* st;
};

__device__ __forceinline__ XcdBarrier xcd_barrier_post(unsigned* bar, volatile LAS unsigned* st) {
    XcdBarrier b; b.bar = bar; b.x = xb_xcc_id(); b.st = st;
    if (threadIdx.x == 0) (void)xb_add(&bar[XB_XCNT(b.x)], 1u);
    return b;
}
__device__ __forceinline__ void xcd_barrier_complete(unsigned* bar, unsigned x, unsigned& nloc, unsigned& nx) {
    const unsigned G = gridDim.x * gridDim.y * gridDim.z;
    unsigned sum, cnt, mine, sp = 0u;
    for (;;) {
        sum = 0u; cnt = 0u; mine = 0u;
#pragma unroll
        for (unsigned j = 0; j < 16; ++j) { const unsigned c = xb_ld(&bar[XB_XCNT(j)]); sum += c; cnt += (c > 0u) ? 1u : 0u; mine = (j == x) ? c : mine; }
        if (sum == G) break;
        __builtin_amdgcn_s_sleep(1);
        if ((++sp & 255u) == 0u) { if (xb_ld(&bar[XB_TMO])) break; if (sp > XB_SPIN_CAP) { atomicAdd(&bar[XB_TMO], 1u); break; } }
    }
    nloc = mine > 0u ? mine : 1u; nx = cnt > 0u ? cnt : 1u;
}

__device__ __forceinline__ void xcd_barrier(const XcdBarrier& b) {
    asm volatile("s_waitcnt vmcnt(0)" ::: "memory");
    __syncthreads();
    if (threadIdx.x == 0) {
        unsigned* bar = b.bar;
        __builtin_amdgcn_s_waitcnt(0);
        unsigned nloc = b.st[0], nx = b.st[1];
        if (nloc == 0u) { xcd_barrier_complete(bar, b.x, nloc, nx); b.st[0] = nloc; b.st[1] = nx; }
        const unsigned old = xb_add(&bar[XB_XSUB(b.x)], 1u);
        const unsigned gen = old / nloc;
        if (old + 1u == (gen + 1u) * nloc) {
            __builtin_amdgcn_fence(__ATOMIC_RELEASE, "agent");
            asm volatile("s_waitcnt vmcnt(0)" ::: "memory");
            const unsigned og = xb_add(&bar[XB_TOP], 1u);
            const unsigned tg = og / nx;
            if (og + 1u == (tg + 1u) * nx) xb_add(&bar[XB_TOPGEN], 1u);
            else XB_SPIN(xb_ld(&bar[XB_TOPGEN]) == tg, bar);
            __builtin_amdgcn_fence(__ATOMIC_ACQUIRE, "agent");
            xb_add(&bar[XB_XGEN(b.x)], 1u);
            asm volatile("s_waitcnt vmcnt(0)" ::: "memory");
        } else {
            XB_SPIN(xb_ld(&bar[XB_XGEN(b.x)]) == gen, bar);
            __builtin_amdgcn_fence(__ATOMIC_ACQUIRE, "agent");
            asm volatile("s_waitcnt vmcnt(0)" ::: "memory");
        }
    }
    __syncthreads();
}
struct Args { const float* in[20]; float* out; unsigned char* ws; int ph_lo, ph_hi; };
typedef const __attribute__((address_space(4))) Args* KArgs;
__device__ __forceinline__ KArgs get_args() { KArgs p = (KArgs)__builtin_amdgcn_kernarg_segment_ptr(); asm volatile("" : "+s"(p)); return p; }
struct Frame {
    LAS unsigned char* lds;
    volatile LAS unsigned* MISC;
    int tid, lane, wave;
    int vcu, G;
};
#define WSP(A, T, off) ((T*)((A)->ws + (off)))
enum { I_XP = 0, I_XS, I_CP, I_CS, I_WADA, I_BADA, I_GMIX, I_WIN, I_DECF, I_DECB, I_GNG, I_WPOOL, I_PSCALE, I_WOUT, I_GFFN, I_WUP, I_CONVW, I_CONVB, I_WDOWN, I_GFINAL };

__device__ __forceinline__ float wave_sum(float v) {
#pragma unroll
    for (int o = 1; o < 64; o <<= 1) v += __shfl_xor(v, o);
    return v;
}
__device__ __forceinline__ int dst_row_in(int n) {
    if (n >= 1024) return n;
    const int d = n & 63, nn = d >> 5, i = (d & 31) >> 2, j = d & 3; return (n & ~63) + 8 * i + 4 * nn + j;
}
__device__ __forceinline__ int dst_row_up(int n) {
    const int lin = n >= DFF ? 1 : 0, f = n - lin * DFF; return 256 * (f >> 7) + 128 * lin + (f & 127);
}
template <int MODE>
__device__ __forceinline__ void p0_transpose_item(const float* W, int K, int N, bf16* WT, LAS float* scr, int item, int lane) {
    const int nblk = N / 32, kb = item / nblk, nb = item % nblk, k0 = 64 * kb, n0 = 32 * nb;
#pragma unroll 8
    for (int i = 0; i < 32; ++i) { const int kk = 2 * i + (lane >> 5); scr[kk * 33 + (lane & 31)] = W[(size_t)(k0 + kk) * N + n0 + (lane & 31)]; }
    LDS_WAIT(); asm volatile("" ::: "memory");
    const int c = lane & 7;
#pragma unroll
    for (int j = 0; j < 4; ++j) { const int n = (lane >> 3) + 8 * j; const LAS float* s = scr + (8 * c) * 33 + n;
        v4u o; o.x = pk2(s[0 * 33], s[1 * 33]); o.y = pk2(s[2 * 33], s[3 * 33]); o.z = pk2(s[4 * 33], s[5 * 33]); o.w = pk2(s[6 * 33], s[7 * 33]);
        const int nr = n0 + n; const int dr = MODE == 1 ? dst_row_in(nr) : (MODE == 2 ? dst_row_up(nr) : nr);
        *(GAS v4u*)(WT + (size_t)dr * K + k0 + 8 * c) = o; }
    LDS_WAIT(); asm volatile("" ::: "memory");
}
__device__ __forceinline__ float lg2_decay(float x) { return (float)(-log1p(exp(-(double)x)) * 1.4426950408889634); }
__device__ __forceinline__ void p0_prologue(Frame& F) {
    const KArgs A = get_args();
    {
        LAS float* sc = (LAS float*)(F.lds);
        LAS float* red = (LAS float*)(F.lds + 49152);
        for (int i = F.tid; i < NSEQ * D; i += NWAVES * 64) { const int b = i >> 10, k = i & 1023; const float cv = b < 8 ? A->in[I_CP][b * D + k] : A->in[I_CS][(b - 8) * D + k]; sc[i] = cv * sigmoidf_(cv); }
        __syncthreads();
        for (int cg = blockIdx.x; cg < 256; cg += F.G) {
            const int col = F.tid & 31, kr = F.tid >> 5;
            float a[NSEQ];
#pragma unroll
            for (int b = 0; b < NSEQ; ++b) a[b] = 0.f;
            if (col < 24) {
                const float* wp = A->in[I_WADA] + 24 * cg + col;
#pragma unroll 4
                for (int k = kr; k < D; k += 16) { const float w = wp[(size_t)k * 6144];
#pragma unroll
                    for (int b = 0; b < NSEQ; ++b) a[b] += sc[b * D + k] * w; }
#pragma unroll
                for (int b = 0; b < NSEQ; ++b) red[(kr * NSEQ + b) * 24 + col] = a[b];
            }
            __syncthreads();
            if (F.tid < NSEQ * 24) { const int b = F.tid / 24, cc = F.tid % 24; float s = A->in[I_BADA][24 * cg + cc];
#pragma unroll
                for (int r = 0; r < 16; ++r) s += red[(r * NSEQ + b) * 24 + cc];
                WSP(A, float, WS_MOD)[b * 6144 + 24 * cg + cc] = s; }
            __syncthreads();
        }
    }
    if (blockIdx.x == 0 && F.tid < 16) WSP(A, float, WS_DEC)[F.tid] = lg2_decay(F.tid < 8 ? A->in[I_DECF][F.tid] : A->in[I_DECB][F.tid - 8]);
    {
        const int gt = blockIdx.x * (NWAVES * 64) + F.tid, NT = F.G * NWAVES * 64;
        for (int i = gt; i < SEQ * 32; i += NT) { const int pos = i >> 5, fi = i & 31;
            const float invf = (float)exp2(-(double)fi * (13.287712379549449 / 32.0));
            const float ang = (float)pos * invf;
            double rev = (double)ang * 0.15915494309189535; rev -= rint(rev);
            const float r = (float)(rev * 6.283185307179586);
            WSP(A, float, WS_COS)[i] = cosf(r); WSP(A, float, WS_SIN)[i] = sinf(r); }
    }
    {
        LAS float* scr = (LAS float*)(F.lds + RING_OFF + F.wave * 16384);
        const int gw = F.vcu * NWAVES + F.wave, NGW = F.G * NWAVES;
        constexpr int I_IN = (D / 64) * (NIN / 32), I_OUT = (D / 64) * (D / 32), I_UP = (D / 64) * (NUP / 32), I_DN = (DFF / 64) * (D / 32), I_PL = (128 / 64) * (256 / 32);
        constexpr int NITEMS = I_IN + I_OUT + I_UP + I_DN + 4 * I_PL;
        for (int it = gw; it < NITEMS; it += NGW) {
            int r = it;
            if (r < I_IN) { p0_transpose_item<1>(A->in[I_WIN], D, NIN, WSP(A, bf16, WS_WIN), scr, r, F.lane); continue; } r -= I_IN;
            if (r < I_OUT) { p0_transpose_item<0>(A->in[I_WOUT], D, D, WSP(A, bf16, WS_WOUT), scr, r, F.lane); continue; } r -= I_OUT;
            if (r < I_UP) { p0_transpose_item<2>(A->in[I_WUP], D, NUP, WSP(A, bf16, WS_WUP), scr, r, F.lane); continue; } r -= I_UP;
            if (r < I_DN) { p0_transpose_item<0>(A->in[I_WDOWN], DFF, D, WSP(A, bf16, WS_WDOWN), scr, r, F.lane); continue; } r -= I_DN;
            const int g = r / I_PL; r -= g * I_PL;
            p0_transpose_item<0>(A->in[I_WPOOL] + (size_t)g * 128 * 256, 128, 256, WSP(A, bf16, WS_WPOOL) + (size_t)g * 256 * 128, scr, r, F.lane);
        }
    }
}
__device__ __forceinline__ void norm_rows_bf16(Frame& F_, const float* xin, const float* g, const float* scl, const float* shf, int b0, bf16* outp) {
    Frame F = F_; F.lane = launder_v(F_.lane); F.wave = launder_s(F_.wave);
    const int gw = F.vcu * NWAVES + F.wave, NGW = F.G * NWAVES;
    for (int blk = gw; blk < MS / 16; blk += NGW) {
        const int r0 = blk * 16, b = b0 + (r0 >> 13);
        f32x4 ca[4], cb[4];
#pragma unroll
        for (int j = 0; j < 4; ++j) { const int col = 4 * F.lane + 256 * j; const f32x4 gv = *(const GAS f32x4*)(g + col), sv = *(const GAS f32x4*)(scl + (size_t)b * 6144 + col);
            ca[j] = gv * (sv + 1.0f); cb[j] = *(const GAS f32x4*)(shf + (size_t)b * 6144 + col); }
        for (int rr = 0; rr < 16; ++rr) {
            const GAS f32x4* xr = (const GAS f32x4*)(xin + (size_t)(r0 + rr) * D) + F.lane;
            f32x4 v[4]; float s2 = 0.f;
#pragma unroll
            for (int j = 0; j < 4; ++j) { v[j] = xr[64 * j]; s2 += (v[j].x * v[j].x + v[j].y * v[j].y) + (v[j].z * v[j].z + v[j].w * v[j].w); }
            const float rstd = 1.f / sqrtf(wave_sum(s2) * (1.f / D) + EPS);
            GAS v2u* o8 = (GAS v2u*)(outp + (size_t)(r0 + rr) * D) + F.lane;
#pragma unroll
            for (int j = 0; j < 4; ++j) { const f32x4 y = v[j] * rstd * ca[j] + cb[j]; v2u w; w.x = pk2(y.x, y.y); w.y = pk2(y.z, y.w); o8[64 * j] = w; }
        }
    }
}
__device__ __forceinline__ void final_norm_rows(Frame& F_, float* xio, const float* g) {
    Frame F = F_; F.lane = launder_v(F_.lane); F.wave = launder_s(F_.wave);
    const int gw = F.vcu * NWAVES + F.wave, NGW = F.G * NWAVES;
    f32x4 cg[4];
#pragma unroll
    for (int j = 0; j < 4; ++j) cg[j] = *(const GAS f32x4*)(g + 4 * F.lane + 256 * j);
    for (int blk = gw; blk < MS / 16; blk += NGW) {
        for (int rr = 0; rr < 16; ++rr) {
            GAS f32x4* xr = (GAS f32x4*)(xio + (size_t)(blk * 16 + rr) * D) + F.lane;
            f32x4 v[4]; float s2 = 0.f;
#pragma unroll
            for (int j = 0; j < 4; ++j) { v[j] = xr[64 * j]; s2 += (v[j].x * v[j].x + v[j].y * v[j].y) + (v[j].z * v[j].z + v[j].w * v[j].w); }
            const float rstd = 1.f / sqrtf(wave_sum(s2) * (1.f / D) + EPS);
#pragma unroll
            for (int j = 0; j < 4; ++j) xr[64 * j] = v[j] * rstd * cg[j];
        }
    }
}

constexpr int C1_V = 0, C1_KF = 36864, C1_KB = 36864 + 20480;
__device__ __forceinline__ void c1_unit(Frame& F, int u) {
    const KArgs A = get_args();
    LAS unsigned char* L = F.lds;
    const int tid = launder_v(F.tid), lane = tid & 63, w = launder_s(F.wave);
    const int sq = u >> 9, c = (u >> 3) & 63, h = u & 7;
    const bf16* prow = WSP(A, bf16, WS_PROJ) + (size_t)(sq * SEQ + c * 128) * NIN;
    const float l2f = WSP(A, float, WS_DEC)[h], l2b = WSP(A, float, WS_DEC)[8 + h];
#pragma unroll
    for (int i = 0; i < 4; ++i) { const int id = tid + 512 * i, rr = id >> 4, cc = id & 15;
        *(LAS v4u*)(L + C1_V + rr * 288 + cc * 16) = *(const GAS v4u*)(prow + (size_t)rr * NIN + COL_V + h * 128 + cc * 8); }
#pragma unroll
    for (int i = 0; i < 2; ++i) { const int id = tid + 512 * i, rr = id >> 3, cc = id & 7;
        const v4u kv = *(const GAS v4u*)(prow + (size_t)rr * NIN + COL_K + h * 64 + cc * 8);
        const float wf = __builtin_amdgcn_exp2f(l2f * (float)(127 - rr)), wb = __builtin_amdgcn_exp2f(l2b * (float)rr);
        v4u kf, kb;
        kf.x = pk2(bflo(kv.x) * wf, bfhi(kv.x) * wf); kf.y = pk2(bflo(kv.y) * wf, bfhi(kv.y) * wf); kf.z = pk2(bflo(kv.z) * wf, bfhi(kv.z) * wf); kf.w = pk2(bflo(kv.w) * wf, bfhi(kv.w) * wf);
        kb.x = pk2(bflo(kv.x) * wb, bfhi(kv.x) * wb); kb.y = pk2(bflo(kv.y) * wb, bfhi(kv.y) * wb); kb.z = pk2(bflo(kv.z) * wb, bfhi(kv.z) * wb); kb.w = pk2(bflo(kv.w) * wb, bfhi(kv.w) * wb);
        *(LAS v4u*)(L + C1_KF + rr * 160 + cc * 16) = kf; *(LAS v4u*)(L + C1_KB + rr * 160 + cc * 16) = kb; }
    __syncthreads();
    const int g = lane >> 4, q = (lane & 15) >> 2, p = lane & 3, l15 = lane & 15;
    f32x4 af[4], ab[4];
#pragma unroll
    for (int i = 0; i < 4; ++i) { af[i] = (f32x4){0.f, 0.f, 0.f, 0.f}; ab[i] = (f32x4){0.f, 0.f, 0.f, 0.f}; }
#pragma unroll
    for (int kb = 0; kb < 4; ++kb) {
        const int rowa = 32 * kb + 4 * g + q;
        const s16x4 v0 = __builtin_amdgcn_ds_read_tr16_b64_v4i16((LAS s16x4*)(L + C1_V + rowa * 288 + (16 * w + 4 * p) * 2));
        const s16x4 v1 = __builtin_amdgcn_ds_read_tr16_b64_v4i16((LAS s16x4*)(L + C1_V + (rowa + 16) * 288 + (16 * w + 4 * p) * 2));
        const bf16x8 vf = (bf16x8){v0.x, v0.y, v0.z, v0.w, v1.x, v1.y, v1.z, v1.w};
#pragma unroll
        for (int db = 0; db < 4; ++db) {
            const s16x4 f0 = __builtin_amdgcn_ds_read_tr16_b64_v4i16((LAS s16x4*)(L + C1_KF + rowa * 160 + (16 * db + 4 * p) * 2));
            const s16x4 f1 = __builtin_amdgcn_ds_read_tr16_b64_v4i16((LAS s16x4*)(L + C1_KF + (rowa + 16) * 160 + (16 * db + 4 * p) * 2));
            const s16x4 b0 = __builtin_amdgcn_ds_read_tr16_b64_v4i16((LAS s16x4*)(L + C1_KB + rowa * 160 + (16 * db + 4 * p) * 2));
            const s16x4 b1 = __builtin_amdgcn_ds_read_tr16_b64_v4i16((LAS s16x4*)(L + C1_KB + (rowa + 16) * 160 + (16 * db + 4 * p) * 2));
            af[db] = __builtin_amdgcn_mfma_f32_16x16x32_bf16((bf16x8){f0.x, f0.y, f0.z, f0.w, f1.x, f1.y, f1.z, f1.w}, vf, af[db], 0, 0, 0);
            ab[db] = __builtin_amdgcn_mfma_f32_16x16x32_bf16((bf16x8){b0.x, b0.y, b0.z, b0.w, b1.x, b1.y, b1.z, b1.w}, vf, ab[db], 0, 0, 0);
        }
    }
    float* lo = WSP(A, float, WS_LST) + (size_t)u * (2 * 128 * 64) + (16 * w + l15) * 64 + 4 * g;
#pragma unroll
    for (int db = 0; db < 4; ++db) { *(GAS f32x4*)(lo + 16 * db) = af[db]; *(GAS f32x4*)(lo + 128 * 64 + 16 * db) = ab[db]; }
    __syncthreads();
}
__device__ __forceinline__ void c2_scan(Frame& F_) {
    const KArgs A = get_args();
    Frame F = F_; F.tid = launder_v(F_.tid);
    const int NT = F.G * NWAVES * 64;
    for (int gid = blockIdx.x * (NWAVES * 64) + F.tid; gid < SLAB_SEQ * 8 * 2 * 2048; gid += NT) {
        const int e4 = gid & 2047, dir = (gid >> 11) & 1, h = (gid >> 12) & 7, sq = gid >> 15;
        const float Gd = __builtin_amdgcn_exp2f(128.0f * WSP(A, float, WS_DEC)[dir * 8 + h]);
        const size_t ustride = (size_t)8 * (2 * 128 * 64);
        const size_t base = ((size_t)(sq * 512 + h) * 2 + dir) * (128 * 64) + (size_t)e4 * 4;
        const float* lp = WSP(A, float, WS_LST) + base; bf16* sp = WSP(A, bf16, WS_SST) + base;
        f32x4 S = (f32x4){0.f, 0.f, 0.f, 0.f};
#pragma unroll 8
        for (int i = 0; i < 64; ++i) { const int c = dir ? 63 - i : i;
            v2u o; o.x = pk2(S.x, S.y); o.y = pk2(S.z, S.w); *(GAS v2u*)(sp + c * ustride) = o;
            const f32x4 l = *(const GAS f32x4*)(lp + c * ustride); S = S * Gd + l; }
    }
}
constexpr int C3_PRAW = 0, C3_PA = 36864, C3_WP = 36864 + 34816;
constexpr int C3_K = 0, C3_V = 18432, C3_SF = 18432 + 36864, C3_SB = C3_SF + 18432;
__device__ __forceinline__ void c3_unit(Frame& F, int u) {
    const KArgs A = get_args();
    LAS unsigned char* L = F.lds;
    const int tid = launder_v(F.tid), lane = tid & 63, w = launder_s(F.wave);
    const int sq = u >> 9, c = (u >> 3) & 63, h = u & 7, gi = h >> 1, oh = h & 1;
    const int r0 = sq * SEQ + c * 128;
    const int g = lane >> 4, q = (lane & 15) >> 2, p = lane & 3, l15 = lane & 15;
    for (int id = tid; id < 144 * 16; id += 512) { const int rr = id >> 4, cc = id & 15, pos = c * 128 - 8 + rr;
        v4u val = (v4u){0u, 0u, 0u, 0u};
        if (pos >= 0 && pos < SEQ) val = *(const GAS v4u*)(WSP(A, bf16, WS_PROJ) + (size_t)(sq * SEQ + pos) * NIN + COL_P + gi * 128 + cc * 8);
        *(LAS v4u*)(L + C3_PRAW + rr * 256 + cc * 16) = val; }
    { const bf16* wp = WSP(A, bf16, WS_WPOOL) + (size_t)(gi * 256 + oh * 128) * 128;
#pragma unroll
      for (int i = 0; i < 4; ++i) { const int id = tid + 512 * i, rr = id >> 4, cc = id & 15;
          *(LAS v4u*)(L + C3_WP + rr * 272 + cc * 16) = *(const GAS v4u*)(wp + rr * 128 + cc * 8); } }
    __syncthreads();
    { const int ch = tid & 127, rg = tid >> 7, half = 1 << gi, n0 = rg * 32;
      const LAS unsigned short* pr = (const LAS unsigned short*)(L + C3_PRAW) + ch;
      float s = 0.f;
      for (int k = n0 + 8 - half; k < n0 + 8 + half; ++k) s += bf2f(pr[k * 128]);
      for (int n = n0; n < n0 + 32; ++n) { const int pos = c * 128 + n; const int lo = pos - half < 0 ? 0 : pos - half, hi = pos + half > SEQ ? SEQ : pos + half;
          const float pooled = s / (float)(hi - lo) - bf2f(pr[(n + 8) * 128]);
          *((LAS unsigned short*)(L + C3_PA + n * 272) + ch) = (unsigned short)f2bf(pooled);
          s += bf2f(pr[(n + 8 + half) * 128]) - bf2f(pr[(n + 8 - half) * 128]); } }
    __syncthreads();
    f32x4 accp[8];
#pragma unroll
    for (int i = 0; i < 8; ++i) accp[i] = (f32x4){0.f, 0.f, 0.f, 0.f};
#pragma unroll
    for (int kb = 0; kb < 4; ++kb) {
        const bf16x8 a = *(const LAS bf16x8*)(L + C3_PA + (16 * w + l15) * 272 + (32 * kb + 8 * g) * 2);
#pragma unroll
        for (int nb = 0; nb < 8; ++nb) { const bf16x8 b = *(const LAS bf16x8*)(L + C3_WP + (16 * nb + l15) * 272 + (32 * kb + 8 * g) * 2);
            accp[nb] = __builtin_amdgcn_mfma_f32_16x16x32_bf16(b, a, accp[nb], 0, 0, 0); }
    }
    __syncthreads();
    const bf16* prow = WSP(A, bf16, WS_PROJ) + (size_t)r0 * NIN;
#pragma unroll
    for (int i = 0; i < 2; ++i) { const int id = tid + 512 * i, rr = id >> 3, cc = id & 7;
        *(LAS v4u*)(L + C3_K + rr * 144 + cc * 16) = *(const GAS v4u*)(prow + (size_t)rr * NIN + COL_K + h * 64 + cc * 8);
        *(LAS v4u*)(L + C3_SF + rr * 144 + cc * 16) = *(const GAS v4u*)(WSP(A, bf16, WS_SST) + (size_t)u * (2 * 128 * 64) + rr * 64 + cc * 8);
        *(LAS v4u*)(L + C3_SB + rr * 144 + cc * 16) = *(const GAS v4u*)(WSP(A, bf16, WS_SST) + (size_t)u * (2 * 128 * 64) + 128 * 64 + rr * 64 + cc * 8); }
#pragma unroll
    for (int i = 0; i < 4; ++i) { const int id = tid + 512 * i, rr = id >> 4, cc = id & 15;
        *(LAS v4u*)(L + C3_V + rr * 288 + cc * 16) = *(const GAS v4u*)(prow + (size_t)rr * NIN + COL_V + h * 128 + cc * 8); }
    const int n = 16 * w + l15;
    v4u qraw[2];
#pragma unroll
    for (int kb = 0; kb < 2; ++kb) qraw[kb] = *(const GAS v4u*)(prow + (size_t)n * NIN + COL_Q + h * 64 + 32 * kb + 8 * g);
    const float l2f = WSP(A, float, WS_DEC)[h], l2b = WSP(A, float, WS_DEC)[8 + h];
    __syncthreads();
    f32x4 sc[8];
#pragma unroll
    for (int mb = 0; mb < 8; ++mb) { sc[mb] = (f32x4){0.f, 0.f, 0.f, 0.f};
#pragma unroll
        for (int kb = 0; kb < 2; ++kb) { const bf16x8 kf = *(const LAS bf16x8*)(L + C3_K + (16 * mb + l15) * 144 + (32 * kb + 8 * g) * 2);
            sc[mb] = __builtin_amdgcn_mfma_f32_16x16x32_bf16(kf, __builtin_bit_cast(bf16x8, qraw[kb]), sc[mb], 0, 0, 0); } }
    bf16x8 pf[4];
#pragma unroll
    for (int kb = 0; kb < 4; ++kb) { float v[8];
#pragma unroll
        for (int t = 0; t < 2; ++t)
#pragma unroll
            for (int e = 0; e < 4; ++e) { const int m = 32 * kb + 16 * t + 4 * g + e, df = n - m;
                const float dec = df >= 0 ? __builtin_amdgcn_exp2f(l2f * (float)df) : __builtin_amdgcn_exp2f(l2b * (float)(-df));
                v[4 * t + e] = sc[2 * kb + t][e] * dec; }
        v4u pw; pw.x = pk2(v[0], v[1]); pw.y = pk2(v[2], v[3]); pw.z = pk2(v[4], v[5]); pw.w = pk2(v[6], v[7]);
        pf[kb] = __builtin_bit_cast(bf16x8, pw); }
    f32x4 ao[8];
#pragma unroll
    for (int i = 0; i < 8; ++i) ao[i] = (f32x4){0.f, 0.f, 0.f, 0.f};
#pragma unroll
    for (int kb = 0; kb < 4; ++kb) { const int rowa = 32 * kb + 4 * g + q;
#pragma unroll
        for (int nb = 0; nb < 8; ++nb) {
            const s16x4 v0 = __builtin_amdgcn_ds_read_tr16_b64_v4i16((LAS s16x4*)(L + C3_V + rowa * 288 + (16 * nb + 4 * p) * 2));
            const s16x4 v1 = __builtin_amdgcn_ds_read_tr16_b64_v4i16((LAS s16x4*)(L + C3_V + (rowa + 16) * 288 + (16 * nb + 4 * p) * 2));
            ao[nb] = __builtin_amdgcn_mfma_f32_16x16x32_bf16((bf16x8){v0.x, v0.y, v0.z, v0.w, v1.x, v1.y, v1.z, v1.w}, pf[kb], ao[nb], 0, 0, 0); } }
    { const float dqf = __builtin_amdgcn_exp2f(l2f * (float)(n + 1)), dqb = __builtin_amdgcn_exp2f(l2b * (float)(128 - n));
#pragma unroll
      for (int kb = 0; kb < 2; ++kb) { const v4u qv = qraw[kb]; v4u qf, qb;
          qf.x = pk2(bflo(qv.x) * dqf, bfhi(qv.x) * dqf); qf.y = pk2(bflo(qv.y) * dqf, bfhi(qv.y) * dqf); qf.z = pk2(bflo(qv.z) * dqf, bfhi(qv.z) * dqf); qf.w = pk2(bflo(qv.w) * dqf, bfhi(qv.w) * dqf);
          qb.x = pk2(bflo(qv.x) * dqb, bfhi(qv.x) * dqb); qb.y = pk2(bflo(qv.y) * dqb, bfhi(qv.y) * dqb); qb.z = pk2(bflo(qv.z) * dqb, bfhi(qv.z) * dqb); qb.w = pk2(bflo(qv.w) * dqb, bfhi(qv.w) * dqb);
#pragma unroll
          for (int nb = 0; nb < 8; ++nb) {
              const bf16x8 sf = *(const LAS bf16x8*)(L + C3_SF + (16 * nb + l15) * 144 + (32 * kb + 8 * g) * 2);
              const bf16x8 sb = *(const LAS bf16x8*)(L + C3_SB + (16 * nb + l15) * 144 + (32 * kb + 8 * g) * 2);
              ao[nb] = __builtin_amdgcn_mfma_f32_16x16x32_bf16(sf, __builtin_bit_cast(bf16x8, qf), ao[nb], 0, 0, 0);
              ao[nb] = __builtin_amdgcn_mfma_f32_16x16x32_bf16(sb, __builtin_bit_cast(bf16x8, qb), ao[nb], 0, 0, 0); } } }
    float s1 = 0.f;
#pragma unroll
    for (int nb = 0; nb < 8; ++nb) s1 += (ao[nb].x + ao[nb].y) + (ao[nb].z + ao[nb].w);
    s1 += __shfl_xor(s1, 16); s1 += __shfl_xor(s1, 32);
    const float mu = s1 * (1.f / 128.f); float s2 = 0.f;
#pragma unroll
    for (int nb = 0; nb < 8; ++nb) { const f32x4 dd = ao[nb] - mu; s2 += (dd.x * dd.x + dd.y * dd.y) + (dd.z * dd.z + dd.w * dd.w); }
    s2 += __shfl_xor(s2, 16); s2 += __shfl_xor(s2, 32);
    const float rstd = 1.f / sqrtf(s2 * (1.f / 128.f) + EPS);
    const bf16* grow = prow + (size_t)n * NIN + h * 128 + 4 * g;
    bf16* orow = WSP(A, bf16, WS_MERGED) + (size_t)(r0 + n) * D + h * 128 + 4 * g;
#pragma unroll
    for (int nb = 0; nb < 8; ++nb) {
        const v2u gs = *(const GAS v2u*)(grow + COL_GSW + 16 * nb), ga = *(const GAS v2u*)(grow + COL_GA + 16 * nb), gb = *(const GAS v2u*)(grow + COL_GB + 16 * nb);
        const f32x4 gain = *(const GAS f32x4*)(A->in[I_GNG] + h * 128 + 16 * nb + 4 * g), ps = *(const GAS f32x4*)(A->in[I_PSCALE] + h * 128 + 16 * nb + 4 * g);
        const float gsv[4] = {bflo(gs.x), bfhi(gs.x), bflo(gs.y), bfhi(gs.y)}, gav[4] = {bflo(ga.x), bfhi(ga.x), bflo(ga.y), bfhi(ga.y)}, gbv[4] = {bflo(gb.x), bfhi(gb.x), bflo(gb.y), bfhi(gb.y)};
        float o[4];
#pragma unroll
        for (int e = 0; e < 4; ++e) { const float y = (ao[nb][e] - mu) * rstd * gain[e];
            const float ba = gsv[e] * sigmoidf_(gsv[e]) * y;
            o[e] = sigmoidf_(gav[e]) * ba + sigmoidf_(gbv[e]) * (accp[nb][e] * ps[e]); }
        v2u ow; ow.x = pk2(o[0], o[1]); ow.y = pk2(o[2], o[3]); *(GAS v2u*)(orow + 16 * nb) = ow;
    }
    __syncthreads();
}
__device__ __forceinline__ float gelu_tanh(float x) { const float u = 0.7978845608028654f * (x + 0.044715f * x * x * x); return x / (1.0f + __expf(-2.0f * u)); }
__device__ __forceinline__ void conv_gelu_phase(Frame& F_) {
    const KArgs A = get_args();
    Frame F = F_; F.tid = launder_v(F_.tid);
    const int NT = F.G * NWAVES * 64;
    const bf16* UP = WSP(A, bf16, WS_PROJ);
    for (int task = blockIdx.x * (NWAVES * 64) + F.tid; task < (MS / 16) * (DFF / 8); task += NT) {
        const int ck = task % (DFF / 8), run = task / (DFF / 8), f0 = ck * 8, r0 = run * 16;
        const int ca = 256 * (f0 >> 7) + (f0 & 127);
        float wa[3][8], wl[3][8], ba[8], bl[8];
#pragma unroll
        for (int j = 0; j < 3; ++j)
#pragma unroll
            for (int e = 0; e < 8; ++e) { wa[j][e] = A->in[I_CONVW][j * NUP + f0 + e]; wl[j][e] = A->in[I_CONVW][j * NUP + DFF + f0 + e]; }
#pragma unroll
        for (int e = 0; e < 8; ++e) { ba[e] = A->in[I_CONVB][f0 + e]; bl[e] = A->in[I_CONVB][DFF + f0 + e]; }
        v4u pa, pl, ca_, cl_, na, nl; const v4u z = (v4u){0u, 0u, 0u, 0u};
        const bf16* base = UP + (size_t)r0 * NUP + ca;
        if ((r0 & (SEQ - 1)) != 0) { pa = *(const GAS v4u*)(base - NUP); pl = *(const GAS v4u*)(base - NUP + 128); } else { pa = z; pl = z; }
        ca_ = *(const GAS v4u*)(base); cl_ = *(const GAS v4u*)(base + 128);
        for (int rr = 0; rr < 16; ++rr) {
            const int row = r0 + rr;
            if ((row & (SEQ - 1)) != SEQ - 1) { na = *(const GAS v4u*)(base + (size_t)(rr + 1) * NUP); nl = *(const GAS v4u*)(base + (size_t)(rr + 1) * NUP + 128); } else { na = z; nl = z; }
            const unsigned pau[4] = {pa.x, pa.y, pa.z, pa.w}, plu[4] = {pl.x, pl.y, pl.z, pl.w}, cau[4] = {ca_.x, ca_.y, ca_.z, ca_.w}, clu[4] = {cl_.x, cl_.y, cl_.z, cl_.w}, nau[4] = {na.x, na.y, na.z, na.w}, nlu[4] = {nl.x, nl.y, nl.z, nl.w};
            unsigned ow[4];
#pragma unroll
            for (int e2 = 0; e2 < 4; ++e2) {
                const float a0 = bflo(pau[e2]) * wa[0][2 * e2] + bflo(cau[e2]) * wa[1][2 * e2] + bflo(nau[e2]) * wa[2][2 * e2] + ba[2 * e2];
                const float a1 = bfhi(pau[e2]) * wa[0][2 * e2 + 1] + bfhi(cau[e2]) * wa[1][2 * e2 + 1] + bfhi(nau[e2]) * wa[2][2 * e2 + 1] + ba[2 * e2 + 1];
                const float l0 = bflo(plu[e2]) * wl[0][2 * e2] + bflo(clu[e2]) * wl[1][2 * e2] + bflo(nlu[e2]) * wl[2][2 * e2] + bl[2 * e2];
                const float l1 = bfhi(plu[e2]) * wl[0][2 * e2 + 1] + bfhi(clu[e2]) * wl[1][2 * e2 + 1] + bfhi(nlu[e2]) * wl[2][2 * e2 + 1] + bl[2 * e2 + 1];
                ow[e2] = pk2(gelu_tanh(a0) * l0, gelu_tanh(a1) * l1); }
            *(GAS v4u*)(WSP(A, bf16, WS_G) + (size_t)row * DFF + f0) = (v4u){ow[0], ow[1], ow[2], ow[3]};
            pa = ca_; pl = cl_; ca_ = na; cl_ = nl;
        }
    }
}
#ifndef EN_P0
#define EN_P0 1
#endif
#ifndef EN_P1
#define EN_P1 1
#endif
#ifndef EN_P2
#define EN_P2 1
#endif
#ifndef EN_P3
#define EN_P3 1
#endif
#ifndef EN_P4
#define EN_P4 1
#endif
#ifndef EN_P5
#define EN_P5 1
#endif
#ifndef EN_P6
#define EN_P6 1
#endif
#ifndef EN_P7
#define EN_P7 1
#endif
#ifndef EN_P8
#define EN_P8 1
#endif
#ifndef EN_P9
#define EN_P9 1
#endif
#ifndef EN_P10
#define EN_P10 1
#endif
#ifndef EN_P11
#define EN_P11 1
#endif
__global__ void __launch_bounds__(NWAVES * 64, 2) enc_fwd(Args args) {
    extern __shared__ __attribute__((aligned(16))) unsigned char lds[];
    Frame F;
    F.lds = (LAS unsigned char*)lds;
    F.MISC = (volatile LAS unsigned*)(F.lds + MISC_OFF);
    F.tid = threadIdx.x; F.lane = F.tid & 63; F.wave = __builtin_amdgcn_readfirstlane(F.tid >> 6);
    F.G = gridDim.x; { const int bx = blockIdx.x; F.vcu = (F.G % 8 == 0) ? (bx % 8) * (F.G / 8) + bx / 8 : bx; }
    for (int u = F.tid; u < (LDS_BYTES - LDSCTL_OFF) / 4; u += NWAVES * 64) ((LAS unsigned*)(F.lds + LDSCTL_OFF))[u] = 0u;
    __syncthreads();
    XcdBarrier bar; bar.bar = (unsigned*)(args.ws + WS_CTL) + CW_BAR; bar.x = 0; bar.st = nullptr;
    if (!MK_PER_PHASE) bar = xcd_barrier_post((unsigned*)(args.ws + WS_CTL) + CW_BAR, F.MISC + 8);
#define GRID_BAR() do { if (MK_PER_PHASE) { if (F.tid == 0) __hip_atomic_store((gu32*)bar.bar - CW_BAR + CW_TMO, 0xBADBA0u, RLX_AGENT); } else { xcd_barrier(bar); } } while (0)
    const int lo = args.ph_lo, hi = args.ph_hi;
#define IN(k) (lo <= (k) && (k) < hi)
#define BOTH(k) (IN(k) && IN((k) + 1))
#define XS(A, s) ((s) < 2 ? (A)->in[I_XP] + (size_t)(s) * MS * D : (A)->in[I_XS])
#define OUTS(A, s) ((A)->out + (size_t)(s) * MS * D)

    if (EN_P0 && IN(0)) { p0_prologue(F); if (BOTH(0)) GRID_BAR(); }

    for (int s = 0; s < NSLAB; ++s) {
        const int pb = 1 + s * PH_PER_SLAB;
        const int b0 = s * SLAB_SEQ;
        if (EN_P1 && IN(pb + 0)) { const KArgs A = get_args();
            norm_rows_bf16(F, XS(A, s), A->in[I_GMIX], WSP(A, float, WS_MOD) + 1 * D, WSP(A, float, WS_MOD) + 0 * D, b0, WSP(A, bf16, WS_H)); if (BOTH(pb + 0)) GRID_BAR(); }
        if (EN_P2 && IN(pb + 1)) { const KArgs A = get_args();
            pg8::Gemm g{WSP(A, bf16, WS_H), WSP(A, bf16, WS_WIN), MS, NIN, D}; pg8::StaticOrder S; S.init(MS, NIN, F.G, (int)blockIdx.x);
            pg8::EpiProj E{WSP(A, bf16, WS_PROJ), NIN, WSP(A, float, WS_COS), WSP(A, float, WS_SIN)};
            pg8::gemm_phase<pg8::EpiProj, pg8::StaticOrder, PG8_ALIGN, PG8_SP2>(F.lds + RING_OFF, g, S, E);
            if (BOTH(pb + 1)) GRID_BAR();
        }
        if (EN_P3 && IN(pb + 2)) { for (int u = F.vcu; u < NUNIT; u += F.G) c1_unit(F, u); if (BOTH(pb + 2)) GRID_BAR(); }
        if (EN_P4 && IN(pb + 3)) { c2_scan(F); if (BOTH(pb + 3)) GRID_BAR(); }
        if (EN_P5 && IN(pb + 4)) { for (int u = F.vcu; u < NUNIT; u += F.G) c3_unit(F, u); if (BOTH(pb + 4)) GRID_BAR(); }
        if (EN_P6 && IN(pb + 5)) { const KArgs A = get_args();
            pg8::Gemm g{WSP(A, bf16, WS_MERGED), WSP(A, bf16, WS_WOUT), MS, D, D}; pg8::StaticOrder S; S.init(MS, D, F.G, (int)blockIdx.x);
            pg8::EpiRes E{XS(A, s), OUTS(A, s), WSP(A, float, WS_MOD) + 2 * D, b0};
            pg8::gemm_phase<pg8::EpiRes, pg8::StaticOrder, PG8_ALIGN, PG8_SP2>(F.lds + RING_OFF, g, S, E);
            if (BOTH(pb + 5)) GRID_BAR();
        }
        if (EN_P7 && IN(pb + 6)) { const KArgs A = get_args();
            norm_rows_bf16(F, OUTS(A, s), A->in[I_GFFN], WSP(A, float, WS_MOD) + 4 * D, WSP(A, float, WS_MOD) + 3 * D, b0, WSP(A, bf16, WS_H)); if (BOTH(pb + 6)) GRID_BAR(); }
        if (EN_P8 && IN(pb + 7)) { const KArgs A = get_args();
            pg8::Gemm g{WSP(A, bf16, WS_H), WSP(A, bf16, WS_WUP), MS, NUP, D}; pg8::StaticOrder S; S.init(MS, NUP, F.G, (int)blockIdx.x);
            pg8::EpiStoreBf16 E{WSP(A, bf16, WS_PROJ), NUP};
            pg8::gemm_phase<pg8::EpiStoreBf16, pg8::StaticOrder, PG8_ALIGN, PG8_SP2>(F.lds + RING_OFF, g, S, E);
            if (BOTH(pb + 7)) GRID_BAR();
        }
        if (EN_P9 && IN(pb + 8)) { conv_gelu_phase(F); if (BOTH(pb + 8)) GRID_BAR(); }
        if (EN_P10 && IN(pb + 9)) { const KArgs A = get_args();
            pg8::Gemm g{WSP(A, bf16, WS_G), WSP(A, bf16, WS_WDOWN), MS, D, DFF}; pg8::StaticOrder S; S.init(MS, D, F.G, (int)blockIdx.x);
            pg8::EpiRes E{OUTS(A, s), OUTS(A, s), WSP(A, float, WS_MOD) + 5 * D, b0};
            pg8::gemm_phase<pg8::EpiRes, pg8::StaticOrder, PG8_ALIGN, PG8_SP2>(F.lds + RING_OFF, g, S, E);
            if (BOTH(pb + 9)) GRID_BAR();
        }
        if (EN_P11 && IN(pb + 10)) { const KArgs A = get_args(); final_norm_rows(F, OUTS(A, s), A->in[I_GFINAL]); if (BOTH(pb + 10)) GRID_BAR(); }
    }
#undef IN
#undef BOTH
}

extern "C" void kernel_launch(void* const* d_in, const int* in_sizes, int n_in, void* d_out, int out_size, void* d_ws, size_t ws_size, hipStream_t stream) {
    static int grid = 0;
    if (grid == 0) {
        if (n_in != 20 || out_size != NSEQ * SEQ * D || ws_size < WS_END) { fprintf(stderr, "kernel_launch: unexpected shapes (n_in %d, out %d, ws %zu); nothing launched\n", n_in, out_size, ws_size); grid = -1; return; }
        int dev = 0, cus = 0, per_cu = 0;
        if (hipGetDevice(&dev) != hipSuccess || hipDeviceGetAttribute(&cus, hipDeviceAttributeMultiprocessorCount, dev) != hipSuccess) { grid = -1; return; }
        if (hipFuncSetAttribute((const void*)enc_fwd, hipFuncAttributeMaxDynamicSharedMemorySize, LDS_BYTES) != hipSuccess) { fprintf(stderr, "kernel_launch: hipFuncSetAttribute failed\n"); grid = -1; return; }
        if (hipOccupancyMaxActiveBlocksPerMultiprocessor(&per_cu, (const void*)enc_fwd, NWAVES * 64, LDS_BYTES) != hipSuccess || per_cu < 1) fprintf(stderr, "kernel_launch: occupancy query reports %d\n", per_cu);
        (void)hipGetLastError();
        grid = cus;
    }
    if (grid < 0) return;
    if (hipMemsetAsync((char*)d_ws + WS_CTL, 0, CTL_ZERO_BYTES, stream) != hipSuccess) return;
    Args a{};
    for (int i = 0; i < 20; ++i) a.in[i] = (const float*)d_in[i];
    a.out = (float*)d_out; a.ws = (unsigned char*)d_ws;
#if MK_PER_PHASE
    for (int p = 0; p < NPHASE; ++p) { a.ph_lo = p; a.ph_hi = p + 1; hipLaunchKernelGGL(enc_fwd, dim3(grid), dim3(NWAVES * 64), LDS_BYTES, stream, a); }
#else
    a.ph_lo = 0; a.ph_hi = NPHASE;
    hipLaunchKernelGGL(enc_fwd, dim3(grid), dim3(NWAVES * 64), LDS_BYTES, stream, a);
#endif
}
```

```cpp
#include <hip/hip_runtime.h>
#include <cstdio>
#include <cstdint>
#define NT_STORE 0
#ifndef PG8_WGM
#define PG8_WGM 8
#endif
namespace pg8 {
#define PG8_LAS __attribute__((address_space(3)))
typedef unsigned short bf16_t;
typedef short bf16x8 __attribute__((ext_vector_type(8)));
typedef float f32x4 __attribute__((ext_vector_type(4)));
typedef unsigned u32x4 __attribute__((ext_vector_type(4)));
constexpr int BM = 256, BK = 64, HALF = 128, HTB = HALF * BK * 2  , STAGE_BYTES = 8 * HTB, NXCD = 8, WGM = PG8_WGM;

__host__ __device__ __forceinline__ int lds_byte(int r, int c) { const int st = (r >> 4) * 2 + (c >> 5), rr = r & 15, cc = c & 31, ob = rr * 64 + cc * 2; return st * 1024 + (ob ^ (((ob >> 9) & 1) << 5)); }
__host__ __device__ __forceinline__ void stage_rc(int b, int& R, int& C) { const int st = b / 1024, sb = b % 1024, swz = sb ^ (((sb >> 9) & 1) << 5); R = (st >> 1) * 16 + swz / 64; C = (st & 1) * 32 + (swz % 64) / 2; }
__host__ __device__ __forceinline__ int perm32(int rho) { const int n = rho >> 4, i = rho & 15; return 8 * (i >> 2) + 4 * n + (i & 3); }

struct Unit { int pm, pn; };
struct Gemm { const bf16_t* A; const bf16_t* Bt; int M, N, K; int ntx = 0; };

struct StaticOrder {
    int nM, nN, nwg, G, c; int zero = 0;
    __host__ __device__ void init(int M, int N, int G_, int c_) { nM = M / BM; nN = N / BM; nwg = nM * nN; G = G_; c = c_; }
    __host__ __device__ bool next(int i, Unit& u) const {
        const long L = (long)i * G + c; if (L >= nwg) return false;
        int wgid = (int)L; { const int q = nwg / NXCD, r = nwg % NXCD, xcd = wgid % NXCD, off = wgid / NXCD; wgid = (xcd < r ? xcd * (q + 1) : r * (q + 1) + (xcd - r) * q) + off; }
        const int nig = WGM * nN, gid = wgid / nig, fm = gid * WGM, gsz = (nM - fm) < WGM ? (nM - fm) : WGM;
        u.pm = fm + ((wgid % nig) % gsz); u.pn = (wgid % nig) / gsz; if (zero) { u.pm = 0; u.pn = 4; } return true;
    }
    __device__ __forceinline__ void a_ready(const Unit&) const {}
    __device__ __forceinline__ void done(const Unit&) const {}
};
__device__ __forceinline__ unsigned cvt_pk_bf16(float lo, float hi) { unsigned r; asm volatile("v_cvt_pk_bf16_f32 %0, %1, %2" : "=v"(r) : "v"(lo), "v"(hi)); return r; }
typedef float f32x2 __attribute__((ext_vector_type(2)));
#ifndef NT_GATE
#define NT_GATE 0
#endif
#ifndef RELAX_EPI
#define RELAX_EPI 1
#endif
#ifndef RES_GROUP
#define RES_GROUP 1
#endif
#ifndef PROBE_EPIVALU
#define PROBE_EPIVALU 0
#endif
#ifndef PROBE_CONTIG
#define PROBE_CONTIG 0
#endif
#ifndef ROT_FLY
#define ROT_FLY 1
#endif
#ifndef NT_STORE
#define NT_STORE 1
#endif
typedef float f32x2p __attribute__((ext_vector_type(2)));
__device__ __forceinline__ f32x2p gateA2(f32x2p gs, f32x2p ga) {
    const f32x2p xs = gs * -1.4426950408889634f, xa = ga * -1.4426950408889634f;
    f32x2p es, ea; es.x = __builtin_amdgcn_exp2f(xs.x); es.y = __builtin_amdgcn_exp2f(xs.y); ea.x = __builtin_amdgcn_exp2f(xa.x); ea.y = __builtin_amdgcn_exp2f(xa.y);
    const f32x2p d = (es + 1.0f) * (ea + 1.0f);
    f32x2p r; r.x = __builtin_amdgcn_rcpf(d.x); r.y = __builtin_amdgcn_rcpf(d.y);
    return gs * r;
}
__device__ __forceinline__ f32x2p gateB2(f32x2p gb) {
    const f32x2p x = gb * -1.4426950408889634f;
    f32x2p e; e.x = __builtin_amdgcn_exp2f(x.x); e.y = __builtin_amdgcn_exp2f(x.y); e = e + 1.0f;
    f32x2p r; r.x = __builtin_amdgcn_rcpf(e.x); r.y = __builtin_amdgcn_rcpf(e.y);
    return r;
}
struct EpiProj {
    static __device__ __forceinline__ int nops(const Unit& u) { return (u.pn >= 8 && u.pn < 16) ? 8 : 16; }
    static constexpr bool PERM = true, AFTER_DRAIN = false, HAS_PRE = false, ROWPERM = false, HAS_PF = false; static constexpr int NST = 16;
    bf16_t* O; int ldc; const float* cosT; const float* sinT; int dry;
    template <int KIND>
    __device__ __forceinline__ void body(const f32x4 (&acc)[2][2][4][2], int row0, int ocol0, int fi0, float sc) const {
        float invf[4];
        if constexpr (KIND == 1 && ROT_FLY) {
            const bool hi = fi0 >= 16; const int q4 = (fi0 >> 2) & 3;
#define ROT_SEL(a, b, c, d, e_, f_, g_, h_) (hi ? (q4 == 0 ? (e_) : q4 == 1 ? (f_) : q4 == 2 ? (g_) : (h_)) : (q4 == 0 ? (a) : q4 == 1 ? (b) : q4 == 2 ? (c) : (d)))
            invf[0] = ROT_SEL(1.000000000e+00f, 3.162277639e-01f, 1.000000015e-01f, 3.162277490e-02f, 9.999999776e-03f, 3.162277630e-03f, 1.000000047e-03f, 3.162277571e-04f);
            invf[1] = ROT_SEL(7.498942018e-01f, 2.371373773e-01f, 7.498942316e-02f, 2.371373773e-02f, 7.498942316e-03f, 2.371373819e-03f, 7.498941850e-04f, 2.371373703e-04f);
            invf[2] = ROT_SEL(5.623413324e-01f, 1.778279394e-01f, 5.623413250e-02f, 1.778279431e-02f, 5.623413250e-03f, 1.778279431e-03f, 5.623413017e-04f, 1.778279402e-04f);
            invf[3] = ROT_SEL(4.216965139e-01f, 1.333521456e-01f, 4.216964915e-02f, 1.333521400e-02f, 4.216964822e-03f, 1.333521446e-03f, 4.216965172e-04f, 1.333521504e-04f);
#undef ROT_SEL
        }
#pragma unroll
        for (int ai = 0; ai < 2; ++ai)
#pragma unroll
            for (int m = 0; m < 4; ++m) { const int row = row0 + ai * HALF + m * 16; bf16_t* rowp = O + (size_t)row * ldc + ocol0;
                if constexpr (KIND == 2) {
                    f32x4 a0, a1; const f32x4 gs0 = acc[ai][0][m][0], gs1 = acc[ai][0][m][1], ga0 = acc[ai][1][m][0], ga1 = acc[ai][1][m][1];
#pragma unroll
                    for (int hp = 0; hp < 2; ++hp) {
                        const f32x2p r0 = gateA2((f32x2p){gs0[2 * hp], gs0[2 * hp + 1]}, (f32x2p){ga0[2 * hp], ga0[2 * hp + 1]}), r1 = gateA2((f32x2p){gs1[2 * hp], gs1[2 * hp + 1]}, (f32x2p){ga1[2 * hp], ga1[2 * hp + 1]});
                        a0[2 * hp] = r0.x; a0[2 * hp + 1] = r0.y; a1[2 * hp] = r1.x; a1[2 * hp + 1] = r1.y; }
                    u32x4 w; w.x = cvt_pk_bf16(a0[0], a0[1]); w.y = cvt_pk_bf16(a0[2], a0[3]); w.z = cvt_pk_bf16(a1[0], a1[1]); w.w = cvt_pk_bf16(a1[2], a1[3]);
                    if (!dry) { if (NT_STORE) __builtin_nontemporal_store(w, (u32x4*)rowp); else *(u32x4*)rowp = w; }
                } else {
                    f32x4 c4, s4;
                    if constexpr (KIND == 1 && !ROT_FLY) { const int pos = row & 8191; c4 = *(const f32x4*)(cosT + pos * 32 + fi0); s4 = *(const f32x4*)(sinT + pos * 32 + fi0); }
                    if constexpr (KIND == 1 && ROT_FLY) {
                        const float posf = (float)(row & 8191);
#pragma unroll
                        for (int e = 0; e < 4; ++e) { const float ang = posf * invf[e];
                            const float pr = ang * 1.591549367e-01f, er = __builtin_fmaf(ang, 1.591549367e-01f, -pr), fr_ = pr - __builtin_rintf(pr), r = fr_ + __builtin_fmaf(ang, 6.420638243e-09f, er);
                            c4[e] = __builtin_amdgcn_cosf(r); s4[e] = __builtin_amdgcn_sinf(r); } }
#pragma unroll
                    for (int bj = 0; bj < 2; ++bj) { f32x4 v0 = acc[ai][bj][m][0], v1 = acc[ai][bj][m][1];
                        if constexpr (KIND == 1) { const f32x4 o0 = v0 * c4 - v1 * s4, o1 = v0 * s4 + v1 * c4; v0 = o0 * sc; v1 = o1 * sc; }
                        if constexpr (KIND == 3) {
#pragma unroll
                            for (int hp = 0; hp < 2; ++hp) { const f32x2p r0 = gateB2((f32x2p){v0[2 * hp], v0[2 * hp + 1]}), r1 = gateB2((f32x2p){v1[2 * hp], v1[2 * hp + 1]});
                                v0[2 * hp] = r0.x; v0[2 * hp + 1] = r0.y; v1[2 * hp] = r1.x; v1[2 * hp + 1] = r1.y; } }
                        u32x4 w; w.x = cvt_pk_bf16(v0[0], v0[1]); w.y = cvt_pk_bf16(v0[2], v0[3]); w.z = cvt_pk_bf16(v1[0], v1[1]); w.w = cvt_pk_bf16(v1[2], v1[3]);
                        if (!dry) { if (NT_STORE) __builtin_nontemporal_store(w, (u32x4*)(rowp + bj * HALF)); else *(u32x4*)(rowp + bj * HALF) = w; } }
                } }
    }
    __device__ __forceinline__ void operator()(const f32x4 (&acc)[2][2][4][2], const Unit& u, int wr, int wc, int fr, int fq) const {
        const int row0 = u.pm * BM + wr * 64 + fr, lc = wc * 32 + 8 * fq;
        const int pn = u.pn;
        const bool rot = pn < 4, isA = pn >= 8 && pn < 16, isB = pn >= 18; const float sc = (pn >= 2 && pn < 4) ? 0.125f : 1.0f;
        const int ocol0 = isA ? 2048 + 128 * (pn - 8) + lc : (pn < 8 ? 256 * pn + lc : (pn < 18 ? 3072 + 256 * (pn - 16) + lc : 3584 + 256 * (pn - 18) + lc));
        const int fi0 = ((wc & 1) * 32 + 8 * fq) >> 1;
        if (isA) body<2>(acc, row0, ocol0, fi0, sc); else if (isB) body<3>(acc, row0, ocol0, fi0, sc); else if (rot) body<1>(acc, row0, ocol0, fi0, sc); else body<0>(acc, row0, ocol0, fi0, sc);
    }
};
struct EpiStoreBf16 {
    static __device__ __forceinline__ int nops(const Unit&) { return 16; }
    static constexpr bool PERM = true, AFTER_DRAIN = false, HAS_PRE = false, ROWPERM = false, HAS_PF = false; static constexpr int NST = 16;
    bf16_t* O; int ldc;
    __device__ __forceinline__ void operator()(const f32x4 (&acc)[2][2][4][2], const Unit& u, int wr, int wc, int fr, int fq) const {
        const int row0 = u.pm * BM + wr * 64 + fr, col0 = u.pn * BM + wc * 32 + 8 * fq;
#pragma unroll
        for (int ai = 0; ai < 2; ++ai)
#pragma unroll
            for (int m = 0; m < 4; ++m) { bf16_t* rowp = O + (size_t)(row0 + ai * HALF + m * 16) * ldc + col0;
#pragma unroll
                for (int bj = 0; bj < 2; ++bj) { const f32x4 v0 = acc[ai][bj][m][0], v1 = acc[ai][bj][m][1];
                    u32x4 w; w.x = cvt_pk_bf16(v0[0], v0[1]); w.y = cvt_pk_bf16(v0[2], v0[3]); w.z = cvt_pk_bf16(v1[0], v1[1]); w.w = cvt_pk_bf16(v1[2], v1[3]);
                    if (NT_STORE) __builtin_nontemporal_store(w, (u32x4*)(rowp + bj * HALF)); else *(u32x4*)(rowp + bj * HALF) = w; } }
    }
};
template <int CTRL, bool BC> __device__ __forceinline__ float dppf(float old, float src) { return __builtin_bit_cast(float, __builtin_amdgcn_update_dpp(__builtin_bit_cast(int, old), __builtin_bit_cast(int, src), CTRL, 0xf, 0xf, BC)); }
__device__ __forceinline__ float row_above(float above_slot, float cur) { const float t = dppf<0x121, true>(0.f, above_slot); return dppf<0x111, false>(t, cur); }
__device__ __forceinline__ float row_below(float below_slot, float cur) { const float t = dppf<0x12F, true>(0.f, below_slot); return dppf<0x101, false>(t, cur); }
__device__ __forceinline__ float gelu_tanh_e(float x) { const float t = x * (-2.302208198f + -0.10294324f * x * x); return x * __builtin_amdgcn_rcpf(1.0f + __builtin_amdgcn_exp2f(t)); }
__device__ __forceinline__ float mul_ror1(float src, float w) { float d; asm("v_mul_f32_dpp %0, %1, %2 row_ror:1 row_mask:0xf bank_mask:0xf bound_ctrl:1" : "=v"(d) : "v"(src), "v"(w)); return d; }
__device__ __forceinline__ float mul_ror15(float src, float w) { float d; asm("v_mul_f32_dpp %0, %1, %2 row_ror:15 row_mask:0xf bank_mask:0xf bound_ctrl:1" : "=v"(d) : "v"(src), "v"(w)); return d; }
typedef float f32x2g __attribute__((ext_vector_type(2)));
__device__ __forceinline__ f32x2g gelu_mul2(f32x2g a, f32x2g l) {
    const f32x2g t = a * a, u = a * (t * -0.10294324f + -2.302208198f);
    f32x2g d; d.x = __builtin_amdgcn_exp2f(u.x); d.y = __builtin_amdgcn_exp2f(u.y); d = d + 1.0f;
    f32x2g r; r.x = __builtin_amdgcn_rcpf(d.x); r.y = __builtin_amdgcn_rcpf(d.y);
    return (a * l) * r;
}
struct EpiConv {
    static __device__ __forceinline__ int nops(const Unit&) { return 24; }
    static constexpr bool PERM = true, AFTER_DRAIN = false, HAS_PRE = true, ROWPERM = true, HAS_PF = false; static constexpr int NST = 16;
    bf16_t* G; float* EDGE; const float* cw; const float* cb; int dry;
    __device__ __forceinline__ void pre(PG8_LAS unsigned char* lfree, const Unit& nu, int slot, int tid) const {
        if (tid < 256) { const int sg = tid >> 5, tap = sg >> 1, hf = sg & 1;
            const float* src = (tap < 3 ? cw + tap * 5632 : cb) + hf * 2816 + 128 * nu.pn + (tid & 31) * 4;
            __builtin_amdgcn_global_load_lds((const unsigned*)src, (PG8_LAS unsigned*)(lfree + slot * 4096 + (tid >> 6) * 1024), 16, 0, 0); }
    }
    __device__ __forceinline__ void run(const f32x4 (&acc)[2][2][4][2], const Unit& u, int wr, int wc, int fr, int fq, PG8_LAS unsigned char* wslot) const {
        if (dry & 4) return;
        const int lc = wc * 32 + 8 * fq, f0 = 128 * u.pn + lc, row0 = u.pm * BM + wr * 128 + 4 * fr;
        f32x4 w[2][2][4];
#pragma unroll
        for (int n = 0; n < 2; ++n)
#pragma unroll
            for (int bj = 0; bj < 2; ++bj)
#pragma unroll
                for (int t = 0; t < 4; ++t) w[n][bj][t] = *(const PG8_LAS f32x4*)(wslot + ((t * 2 + bj) * 128 + lc + 4 * n) * 4);
#pragma unroll
        for (int ai = 0; ai < 2; ++ai) {
#pragma unroll
            for (int m = 0; m < 4; ++m) {
                unsigned pk[2][2];
#pragma unroll
                for (int n = 0; n < 2; ++n) {
                    f32x4 cv[2];
#pragma unroll
                    for (int bj = 0; bj < 2; ++bj) {
                        f32x4 xa, xb;
                        if (m == 0) {
#pragma unroll
                            for (int e = 0; e < 4; ++e) xa[e] = ai == 0 ? dppf<0x111, true>(0.f, acc[0][bj][3][n][e]) : row_above(acc[0][bj][3][n][e], acc[1][bj][3][n][e]); }
                        else xa = acc[ai][bj][m - 1][n];
                        if (m == 3) {
#pragma unroll
                            for (int e = 0; e < 4; ++e) xb[e] = ai == 1 ? dppf<0x101, true>(0.f, acc[1][bj][0][n][e]) : row_below(acc[1][bj][0][n][e], acc[0][bj][0][n][e]); }
                        else xb = acc[ai][bj][m + 1][n];
                        cv[bj] = (acc[ai][bj][m][n] * w[n][bj][1] + w[n][bj][3]) + (xa * w[n][bj][0] + xb * w[n][bj][2]); }
                    const f32x2g g01 = gelu_mul2((f32x2g){cv[0][0], cv[0][1]}, (f32x2g){cv[1][0], cv[1][1]}), g23 = gelu_mul2((f32x2g){cv[0][2], cv[0][3]}, (f32x2g){cv[1][2], cv[1][3]});
                    pk[n][0] = cvt_pk_bf16(g01.x, g01.y); pk[n][1] = cvt_pk_bf16(g23.x, g23.y); }
                if (!(dry & 1)) { u32x4 o; o.x = pk[0][0]; o.y = pk[0][1]; o.z = pk[1][0]; o.w = pk[1][1]; if (NT_STORE) __builtin_nontemporal_store(o, (u32x4*)(G + (size_t)(row0 + ai * 64 + m) * 2816 + f0)); else *(u32x4*)(G + (size_t)(row0 + ai * 64 + m) * 2816 + f0) = o; }
            }
        }
        bf16_t* eseg = (bf16_t*)EDGE + (size_t)((u.pm * 2 + wr) * 4) * 5632 + u.pn * 256 + lc;
        if (fr == 0 && !(dry & 2)) {
#pragma unroll
            for (int m = 0; m < 2; ++m)
#pragma unroll
                for (int bj = 0; bj < 2; ++bj) { const f32x4 v0 = acc[0][bj][m][0], v1 = acc[0][bj][m][1]; u32x4 o; o.x = cvt_pk_bf16(v0[0], v0[1]); o.y = cvt_pk_bf16(v0[2], v0[3]); o.z = cvt_pk_bf16(v1[0], v1[1]); o.w = cvt_pk_bf16(v1[2], v1[3]);
                    *(u32x4*)(eseg + (size_t)m * 5632 + bj * HALF) = o; } }
        if (fr == 15 && !(dry & 2)) {
#pragma unroll
            for (int m = 2; m < 4; ++m)
#pragma unroll
                for (int bj = 0; bj < 2; ++bj) { const f32x4 v0 = acc[1][bj][m][0], v1 = acc[1][bj][m][1]; u32x4 o; o.x = cvt_pk_bf16(v0[0], v0[1]); o.y = cvt_pk_bf16(v0[2], v0[3]); o.z = cvt_pk_bf16(v1[0], v1[1]); o.w = cvt_pk_bf16(v1[2], v1[3]);
                    *(u32x4*)(eseg + (size_t)m * 5632 + bj * HALF) = o; } }
    }
};
struct EpiGateBf16 {
    static __device__ __forceinline__ int nops(const Unit&) { return 16; }
    static constexpr bool PERM = true, AFTER_DRAIN = false, HAS_PRE = false, ROWPERM = false, HAS_PF = true; static constexpr int NST = 16;
    bf16_t* O; const float* gate; int b0;
    f32x4 gv[2][2];
    __device__ __forceinline__ void prefetch(const Unit& u, int wc, int fq) {
        const float* gp = gate + (size_t)(b0 + ((u.pm * BM) >> 13)) * 6144 + u.pn * BM + wc * 32 + 8 * fq;
#pragma unroll
        for (int bj = 0; bj < 2; ++bj)
#pragma unroll
            for (int n = 0; n < 2; ++n) gv[bj][n] = *(const f32x4*)(gp + bj * HALF + n * 4);
    }
    __device__ __forceinline__ void operator()(const f32x4 (&acc)[2][2][4][2], const Unit& u, int wr, int wc, int fr, int fq) const {
        const int row0 = u.pm * BM + wr * 64 + fr, col0 = u.pn * BM + wc * 32 + 8 * fq;
#pragma unroll
        for (int ai = 0; ai < 2; ++ai)
#pragma unroll
            for (int m = 0; m < 4; ++m) { bf16_t* rowp = O + (size_t)(row0 + ai * HALF + m * 16) * 1024 + col0;
#pragma unroll
                for (int bj = 0; bj < 2; ++bj) { const f32x4 v0 = acc[ai][bj][m][0] * gv[bj][0], v1 = acc[ai][bj][m][1] * gv[bj][1];
                    u32x4 w; w.x = cvt_pk_bf16(v0[0], v0[1]); w.y = cvt_pk_bf16(v0[2], v0[3]); w.z = cvt_pk_bf16(v1[0], v1[1]); w.w = cvt_pk_bf16(v1[2], v1[3]);
                    if (NT_GATE) __builtin_nontemporal_store(w, (u32x4*)(rowp + bj * HALF)); else *(u32x4*)(rowp + bj * HALF) = w; } }
    }
};
struct EpiRes {
    static __device__ __forceinline__ int nops(const Unit&) { return 0; }
    static constexpr bool PERM = false, AFTER_DRAIN = false, HAS_PRE = false, ROWPERM = false, HAS_PF = false; static constexpr int NST = 32;
    const float* base; float* out; const float* gate; int b0;
    __device__ __forceinline__ void operator()(const f32x4 (&acc)[2][2][4][2], const Unit& u, int wr, int wc, int fr, int fq) const {
        const int row0 = u.pm * BM + wr * 64 + fr, col0 = u.pn * BM + wc * 32 + 4 * fq;
        const float* gp = gate + (size_t)(b0 + ((u.pm * BM) >> 13)) * 6144 + col0;
        f32x4 gv[2][2];
#pragma unroll
        for (int bj = 0; bj < 2; ++bj)
#pragma unroll
            for (int n = 0; n < 2; ++n) gv[bj][n] = *(const f32x4*)(gp + bj * HALF + n * 16);
#pragma unroll
        for (int ai = 0; ai < 2; ++ai)
#pragma unroll
            for (int m = 0; m < 4; ++m) { const size_t off = (size_t)(row0 + ai * HALF + m * 16) * 1024 + col0;
#pragma unroll
                for (int bj = 0; bj < 2; ++bj)
#pragma unroll
                    for (int n = 0; n < 2; ++n) { const f32x4 bs = *(const f32x4*)(base + off + bj * HALF + n * 16);
                        *(f32x4*)(out + off + bj * HALF + n * 16) = bs + gv[bj][n] * acc[ai][bj][m][n]; }
                if ((m & (RES_GROUP - 1)) == RES_GROUP - 1) asm volatile("" ::: "memory"); }
    }
};
#ifndef PG8_RELAX
#define PG8_RELAX 1
#endif
#ifndef PG8_ALIGN_LOOP
#define PG8_ALIGN_LOOP 1
#endif
template <class Epi, class Sched, bool ALIGN_EPI = false, bool SP2 = false>
__device__ __forceinline__ void gemm_phase(PG8_LAS unsigned char* lds, const Gemm g, const Sched& S, Epi E) {
    int tid_ = threadIdx.x; asm volatile("" : "+v"(tid_));
    const int tid = tid_, wid = __builtin_amdgcn_readfirstlane(tid >> 6), lane = tid & 63, wr = wid >> 2, wc = wid & 3, fr = lane & 15, fq = lane >> 4;
    const int K = g.K, nt = g.ntx ? g.ntx : K / BK;
    unsigned voffA[2], voffB[2];
#pragma unroll
    for (int i = 0; i < 2; ++i) { int R, C; stage_rc(tid * 16 + i * 8192, R, C); const int Rb = Epi::PERM ? ((R & ~31) + perm32(R & 31)) : R;
        const int Ra = Epi::ROWPERM ? ((R >> 6) * 128 + 4 * (R & 15) + ((R >> 4) & 3)) : R;
        voffA[i] = (unsigned)(Ra * K + C) * 2u; voffB[i] = (unsigned)(Rb * K + C) * 2u; }
    const size_t kstep = (size_t)(BK * 2);
    const size_t hstep = (size_t)HALF * K * 2;
    const size_t hstepA = Epi::ROWPERM ? hstep / 2 : hstep;
    const size_t tstep = 2 * hstep;
    const unsigned ldsw = (unsigned)wid * 1024u;
    const int aoff = lds_byte(wr * 64 + fr, fq * 8), boff = lds_byte(wc * 32 + fr, fq * 8);
#define PG8_SA(b, h) (((b) * 2 + (h)) * HTB)
#define PG8_SB(b, h) ((4 + (b) * 2 + (h)) * HTB)
#ifndef PG8_AUXA
#define PG8_AUXA 0
#endif
#ifndef PG8_AUXB
#define PG8_AUXB 0
#endif
#define PG8_STAGEX(bufoff, gbase, voff, aux) do { _Pragma("unroll") for (int _i = 0; _i < 2; ++_i) \
        __builtin_amdgcn_global_load_lds((const unsigned*)((const char*)(gbase) + (voff)[_i]), (PG8_LAS unsigned*)(lds + (bufoff) + ldsw + _i * 8192), 16, 0, aux); } while (0)
#define PG8_STAGEA(bufoff, gbase, voff) PG8_STAGEX(bufoff, gbase, voff, PG8_AUXA)
#define PG8_STAGEB(bufoff, gbase, voff) PG8_STAGEX(bufoff, gbase, voff, PG8_AUXB)
#define PG8_LDA(dst, b, h) do { _Pragma("unroll") for (int m = 0; m < 4; ++m) _Pragma("unroll") for (int k = 0; k < 2; ++k) dst[m][k] = *(const PG8_LAS bf16x8*)(lds + PG8_SA(b, h) + aoff + m * 2048 + k * 1024); } while (0)
#define PG8_LDB(dst, b, h) do { _Pragma("unroll") for (int n = 0; n < 2; ++n) _Pragma("unroll") for (int k = 0; k < 2; ++k) dst[n][k] = *(const PG8_LAS bf16x8*)(lds + PG8_SB(b, h) + boff + n * 2048 + k * 1024); } while (0)
#define PG8_MMA(ai, bj, At, Bt) do { __builtin_amdgcn_s_setprio(1); _Pragma("unroll") for (int m = 0; m < 4; ++m) _Pragma("unroll") for (int n = 0; n < 2; ++n) _Pragma("unroll") for (int k = 0; k < 2; ++k) \
        acc[ai][bj][m][n] = __builtin_amdgcn_mfma_f32_16x16x32_bf16(Bt[n][k], At[m][k], acc[ai][bj][m][n], 0, 0, 0); __builtin_amdgcn_s_setprio(0); } while (0)
#define PG8_WAIT_V(n) asm volatile("s_waitcnt vmcnt(" #n ")" ::: "memory")
#define PG8_WAIT_V8X asm volatile("s_cmp_eq_u32 %0, 0\n\ts_cbranch_scc1 .Lw8_%=\n\ts_cmp_eq_u32 %0, 8\n\ts_cbranch_scc1 .Lw16_%=\n\ts_cmp_eq_u32 %0, 16\n\ts_cbranch_scc1 .Lw24_%=\n\ts_waitcnt vmcnt(32)\n\ts_branch .Lwe_%=\n" \
        ".Lw8_%=:\n\ts_waitcnt vmcnt(8)\n\ts_branch .Lwe_%=\n.Lw16_%=:\n\ts_waitcnt vmcnt(16)\n\ts_branch .Lwe_%=\n.Lw24_%=:\n\ts_waitcnt vmcnt(24)\n.Lwe_%=:" :: "s"(rx) : "memory", "scc")
#define PG8_WAIT_L(n) asm volatile("s_waitcnt lgkmcnt(" #n ")" ::: "memory")
#define PG8_BAR __builtin_amdgcn_s_barrier()
#define PG8_SCHED __builtin_amdgcn_sched_barrier(0)
    Unit cur, nxt; int ui = 0, xprev = 0;
    if (!S.next(0, cur)) return;
    f32x4 acc[2][2][4][2];
#pragma unroll
    for (int a = 0; a < 2; ++a)
#pragma unroll
        for (int b = 0; b < 2; ++b)
#pragma unroll
            for (int m = 0; m < 4; ++m)
#pragma unroll
                for (int n = 0; n < 2; ++n) acc[a][b][m][n] = (f32x4){0.f, 0.f, 0.f, 0.f};
    bf16x8 At[4][2], B0[2][2], B1[2][2];
    const char* cA = (const char*)g.A + (size_t)cur.pm * tstep; const char* cB = (const char*)g.Bt + (size_t)cur.pn * tstep;
    S.a_ready(cur);
    if constexpr (Epi::HAS_PRE) E.pre(lds + STAGE_BYTES, cur, 0, tid);
    if constexpr (SP2) {
        PG8_STAGEB(PG8_SB(0, 0), cB, voffB); PG8_STAGEB(PG8_SB(0, 1), cB + hstep, voffB); PG8_STAGEA(PG8_SA(0, 0), cA, voffA); PG8_STAGEA(PG8_SA(0, 1), cA + hstepA, voffA);
        if (wr == 1) PG8_BAR;
        PG8_WAIT_V(2); PG8_BAR;
        PG8_STAGEB(PG8_SB(1, 0), cB + kstep, voffB); PG8_STAGEA(PG8_SA(1, 0), cA + kstep, voffA); PG8_STAGEB(PG8_SB(1, 1), cB + hstep + kstep, voffB);
        PG8_WAIT_V(6); PG8_BAR;
    } else {
        PG8_STAGEB(PG8_SB(0, 0), cB, voffB); PG8_STAGEA(PG8_SA(0, 0), cA, voffA); PG8_STAGEB(PG8_SB(0, 1), cB + hstep, voffB); PG8_STAGEA(PG8_SA(0, 1), cA + hstepA, voffA);
        if (wr == 1) PG8_BAR;
        PG8_WAIT_V(4); PG8_BAR;
        PG8_STAGEB(PG8_SB(1, 0), cB + kstep, voffB); PG8_STAGEA(PG8_SA(1, 0), cA + kstep, voffA); PG8_STAGEB(PG8_SB(1, 1), cB + hstep + kstep, voffB);
        PG8_WAIT_V(6); PG8_BAR;
    }
    for (;;) {
        const bool has_next = S.next(ui + 1, nxt);
        const char* nA = has_next ? (const char*)g.A + (size_t)nxt.pm * tstep : cA; const char* nB = has_next ? (const char*)g.Bt + (size_t)nxt.pn * tstep : cB;
#if PG8_ALIGN_LOOP
        asm volatile(".p2align 8");
#endif
        int rx = __builtin_amdgcn_readfirstlane((PG8_RELAX && ui > 0) ? xprev : 0); asm volatile("" : "+s"(rx));
        for (int t = 0; t < nt; t += 2) {
            const bool last = (t == nt - 2);
            const char* a1 = cA + (size_t)(t + 1) * kstep;
            const char* a2 = last ? nA : cA + (size_t)(t + 2) * kstep; const char* b2 = last ? nB : cB + (size_t)(t + 2) * kstep;
            const char* a3 = a2 + kstep; const char* b3 = b2 + kstep;
            if (last && has_next) S.a_ready(nxt);
            if constexpr (Epi::HAS_PF) { if (last) E.prefetch(cur, wc, fq); }
            if constexpr (SP2) {
            PG8_LDB(B0, 0, 0); PG8_LDB(B1, 0, 1); PG8_SCHED; PG8_LDA(At, 0, 0); PG8_STAGEA(PG8_SA(1, 1), a1 + hstepA, voffA);
            PG8_WAIT_V8X; PG8_WAIT_L(0); PG8_BAR; PG8_MMA(0, 0, At, B0); PG8_MMA(0, 1, At, B1); PG8_BAR; PG8_SCHED;
            PG8_LDA(At, 0, 1); PG8_STAGEB(PG8_SB(0, 0), b2, voffB); PG8_STAGEB(PG8_SB(0, 1), b2 + hstep, voffB); PG8_STAGEA(PG8_SA(0, 0), a2, voffA);
            PG8_WAIT_V8X; PG8_WAIT_L(0); PG8_BAR; PG8_MMA(1, 0, At, B0); PG8_MMA(1, 1, At, B1); PG8_BAR; PG8_SCHED;
            asm volatile("s_mov_b32 %0, 0" : "=s"(rx));
            PG8_LDB(B0, 1, 0); PG8_LDB(B1, 1, 1); PG8_SCHED; PG8_LDA(At, 1, 0); PG8_STAGEA(PG8_SA(0, 1), a2 + hstepA, voffA);
            PG8_WAIT_V(8); PG8_WAIT_L(0); PG8_BAR; PG8_MMA(0, 0, At, B0); PG8_MMA(0, 1, At, B1); PG8_BAR; PG8_SCHED;
            PG8_LDA(At, 1, 1); PG8_STAGEB(PG8_SB(1, 0), b3, voffB); PG8_STAGEB(PG8_SB(1, 1), b3 + hstep, voffB); PG8_STAGEA(PG8_SA(1, 0), a3, voffA);
            PG8_WAIT_V(8); PG8_WAIT_L(0); PG8_BAR; PG8_MMA(1, 0, At, B0); PG8_MMA(1, 1, At, B1); PG8_BAR; PG8_SCHED;
            } else {
            PG8_LDB(B0, 0, 0); PG8_SCHED; PG8_LDA(At, 0, 0); PG8_STAGEA(PG8_SA(1, 1), a1 + hstepA, voffA);
            PG8_WAIT_L(8); PG8_BAR; PG8_WAIT_L(0); PG8_MMA(0, 0, At, B0); PG8_BAR; PG8_SCHED;
            PG8_LDB(B1, 0, 1); PG8_STAGEB(PG8_SB(0, 0), b2, voffB);
            PG8_BAR; PG8_WAIT_L(0); PG8_MMA(0, 1, At, B1); PG8_BAR;
            PG8_LDA(At, 0, 1); PG8_STAGEA(PG8_SA(0, 0), a2, voffA);
            PG8_BAR; PG8_WAIT_L(0); PG8_MMA(1, 0, At, B0); PG8_BAR; PG8_SCHED;
            PG8_STAGEB(PG8_SB(0, 1), b2 + hstep, voffB);
            PG8_WAIT_V(6); PG8_BAR; PG8_MMA(1, 1, At, B1); PG8_BAR;
            PG8_LDB(B0, 1, 0); PG8_SCHED; PG8_LDA(At, 1, 0); PG8_STAGEA(PG8_SA(0, 1), a2 + hstepA, voffA);
            PG8_WAIT_L(8); PG8_BAR; PG8_WAIT_L(0); PG8_MMA(0, 0, At, B0); PG8_BAR; PG8_SCHED;
            PG8_LDB(B1, 1, 1); PG8_STAGEB(PG8_SB(1, 0), b3, voffB);
            PG8_BAR; PG8_WAIT_L(0); PG8_MMA(0, 1, At, B1); PG8_BAR;
            PG8_LDA(At, 1, 1); PG8_STAGEA(PG8_SA(1, 0), a3, voffA);
            PG8_BAR; PG8_WAIT_L(0); PG8_MMA(1, 0, At, B0); PG8_BAR; PG8_SCHED;
            PG8_STAGEB(PG8_SB(1, 1), b3 + hstep, voffB);
            PG8_WAIT_V(6); PG8_BAR; PG8_MMA(1, 1, At, B1); PG8_BAR;
            }
        }
        if constexpr (ALIGN_EPI) { if (wr == 0) PG8_BAR; }
        if constexpr (Epi::HAS_PRE) { if (has_next) E.pre(lds + STAGE_BYTES, nxt, (ui + 1) & 1, tid);
            E.run(acc, cur, wr, wc, fr, fq, lds + STAGE_BYTES + (ui & 1) * 4096); S.done(cur); }
        else if constexpr (!Epi::AFTER_DRAIN) { E(acc, cur, wr, wc, fr, fq); S.done(cur); }
        if (!has_next) break;
#pragma unroll
        for (int a = 0; a < 2; ++a)
#pragma unroll
            for (int b = 0; b < 2; ++b)
#pragma unroll
                for (int m = 0; m < 4; ++m)
#pragma unroll
                    for (int n = 0; n < 2; ++n) acc[a][b][m][n] = (f32x4){0.f, 0.f, 0.f, 0.f};
        xprev = Epi::nops(cur); cur = nxt; cA = nA; cB = nB; ++ui;
        if constexpr (ALIGN_EPI) { if (wr == 1) PG8_BAR; }
    }
    PG8_WAIT_V(0);
    if constexpr (!ALIGN_EPI) { if (wr == 0) PG8_BAR; }
    PG8_BAR;
    if constexpr (Epi::AFTER_DRAIN) { E.fused(acc, cur, wr, wc, fr, fq, lds, wid, lane); S.done(cur); }
#undef PG8_SA
#undef PG8_SB
#undef PG8_STAGEX
#undef PG8_STAGEA
#undef PG8_STAGEB
#undef PG8_LDA
#undef PG8_LDB
#undef PG8_MMA
#undef PG8_WAIT_V
#undef PG8_WAIT_L
#undef PG8_WAIT_V8X
#undef PG8_BAR
#undef PG8_SCHED
}
}
#ifndef PG8_SP2
#define PG8_SP2 true
#endif
#ifndef PG8_ALIGN
#define PG8_ALIGN true
#endif
constexpr int NWAVES = 8;
#ifndef MK_PER_PHASE
#define MK_PER_PHASE 0
#endif

constexpr int D = 1024, SEQ = 8192, NSEQ = 12, SLAB_SEQ = 4, NSLAB = 3, MS = SLAB_SEQ * SEQ;
constexpr int NIN = 5632, NUP = 5632, DFF = 2816;
constexpr int NPJ = 4608;
constexpr int COL_Q = 0, COL_K = 512, COL_V = 1024, COL_A = 2048, COL_P = 3072, COL_B = 3584;
constexpr int NUNIT = SLAB_SEQ * 64 * 8;
constexpr float EPS = 1e-6f;
constexpr int PH_PER_SLAB = 11, NPHASE = 1 + NSLAB * PH_PER_SLAB;

constexpr size_t MiB = 1u << 20;
constexpr size_t WS_CTL = 0, CTL_ZERO_BYTES = 1 * MiB;
constexpr size_t WS_MOD = 1 * MiB;
constexpr size_t WS_DEC = 1 * MiB + 512 * 1024;
constexpr size_t WS_COS = 2 * MiB, WS_SIN = 3 * MiB;
constexpr size_t WS_WIN = 4 * MiB;
constexpr size_t WS_WOUT = 16 * MiB;
constexpr size_t WS_WUP = 18 * MiB;
constexpr size_t WS_WDOWN = 30 * MiB;
constexpr size_t WS_WPOOL = 36 * MiB;
constexpr size_t WS_H = 64 * MiB;
constexpr size_t WS_MERGED = 128 * MiB;
constexpr size_t WS_PROJ = 192 * MiB;
constexpr size_t WS_G = 544 * MiB;
constexpr size_t WS_LST = 720 * MiB;
constexpr size_t WS_BB = 784 * MiB;
constexpr size_t WS_SST = 848 * MiB;
constexpr size_t WS_END = 912 * MiB;
constexpr int CW_TMO = 0, CW_CODE = 1, CW_BAR = 4096;

constexpr int RING_OFF = 0, RING_BYTES = 131072;
constexpr int LDS_BYTES = 163840;
constexpr int LDSCTL_OFF = LDS_BYTES - 512, MISC_OFF = LDSCTL_OFF + 320;

#define GAS __attribute__((address_space(1)))
#define LAS __attribute__((address_space(3)))
typedef unsigned short bf16;
typedef unsigned v4u __attribute__((ext_vector_type(4)));
typedef unsigned v2u __attribute__((ext_vector_type(2)));
typedef float f32x4 __attribute__((ext_vector_type(4)));
typedef short bf16x8 __attribute__((ext_vector_type(8)));
typedef short s16x4 __attribute__((ext_vector_type(4)));
typedef GAS unsigned gu32;
#define RLX_AGENT __ATOMIC_RELAXED, __HIP_MEMORY_SCOPE_AGENT
#define LDS_WAIT() asm volatile("s_waitcnt lgkmcnt(0)" ::: "memory")
#define VM_WAIT() asm volatile("s_waitcnt vmcnt(0)" ::: "memory")
__device__ __forceinline__ unsigned f2bf(float f) { unsigned u = __builtin_bit_cast(unsigned, f); return (u + 0x7fffu + ((u >> 16) & 1u)) >> 16; }
typedef float f32x2_ __attribute__((ext_vector_type(2)));
typedef __bf16 bf16x2_ __attribute__((ext_vector_type(2)));
__device__ __forceinline__ unsigned pk2(float lo, float hi) { const bf16x2_ r = __builtin_convertvector((f32x2_){lo, hi}, bf16x2_); return __builtin_bit_cast(unsigned, r); }
__device__ __forceinline__ float bf2f(unsigned short b) { return __builtin_bit_cast(float, ((unsigned)b) << 16); }
__device__ __forceinline__ float bflo(unsigned w) { return __builtin_bit_cast(float, w << 16); }
__device__ __forceinline__ float bfhi(unsigned w) { return __builtin_bit_cast(float, w & 0xffff0000u); }
__device__ __forceinline__ float sigmoidf_(float x) { return 1.0f / (1.0f + __expf(-x)); }
__device__ __forceinline__ int launder_v(int x) { asm volatile("" : "+v"(x)); return x; }
__device__ __forceinline__ int launder_s(int x) { asm volatile("" : "+s"(x)); return x; }
#define XB_TMO      128
#define XB_XCNT(j)  (256  + 64 * (j))
#define XB_XSUB(j)  (1280 + 64 * (j))
#define XB_XGEN(j)  (2304 + 64 * (j))
#define XB_TOP      3328
#define XB_TOPGEN   3392
#define XCD_BAR_WORDS 3456
#define XB_SPIN_CAP (1u << 18)

__device__ __forceinline__ unsigned xb_ld(unsigned* p)              { return __hip_atomic_load(p, __ATOMIC_RELAXED, __HIP_MEMORY_SCOPE_AGENT); }
__device__ __forceinline__ unsigned xb_add(unsigned* p, unsigned v) { return __hip_atomic_fetch_add(p, v, __ATOMIC_RELAXED, __HIP_MEMORY_SCOPE_AGENT); }
__device__ __forceinline__ unsigned xb_xcc_id() { return (unsigned)__builtin_amdgcn_s_getreg((3 << 11) | 20) & 0xFu; }
#define XB_SPIN(cond, bar) do { unsigned _sp = 0; while (cond) { __builtin_amdgcn_s_sleep(1); \
    if ((++_sp & 255u) == 0u) { if (xb_ld(&(bar)[XB_TMO])) break; if (_sp > XB_SPIN_CAP) { atomicAdd(&(bar)[XB_TMO], 1u); break; } } } } while (0)

struct XcdBarrier {
    unsigned* bar; unsigned x;
    volatile LAS unsigned* st;
};

__device__ __forceinline__ XcdBarrier xcd_barrier_post(unsigned* bar, volatile LAS unsigned* st) {
    XcdBarrier b; b.bar = bar; b.x = xb_xcc_id(); b.st = st;
    if (threadIdx.x == 0) (void)xb_add(&bar[XB_XCNT(b.x)], 1u);
    return b;
}
__device__ __forceinline__ void xcd_barrier_complete(unsigned* bar, unsigned x, unsigned& nloc, unsigned& nx) {
    const unsigned G = gridDim.x * gridDim.y * gridDim.z;
    unsigned sum, cnt, mine, sp = 0u;
    for (;;) {
        sum = 0u; cnt = 0u; mine = 0u;
#pragma unroll
        for (unsigned j = 0; j < 16; ++j) { const unsigned c = xb_ld(&bar[XB_XCNT(j)]); sum += c; cnt += (c > 0u) ? 1u : 0u; mine = (j == x) ? c : mine; }
        if (sum == G) break;
        __builtin_amdgcn_s_sleep(1);
        if ((++sp & 255u) == 0u) { if (xb_ld(&bar[XB_TMO])) break; if (sp > XB_SPIN_CAP) { atomicAdd(&bar[XB_TMO], 1u); break; } }
    }
    nloc = mine > 0u ? mine : 1u; nx = cnt > 0u ? cnt : 1u;
}

__device__ __forceinline__ void xcd_barrier(const XcdBarrier& b) {
    asm volatile("s_waitcnt vmcnt(0)" ::: "memory");
    __syncthreads();
    if (threadIdx.x == 0) {
        unsigned* bar = b.bar;
        __builtin_amdgcn_s_waitcnt(0);
        unsigned nloc = b.st[0], nx = b.st[1];
        if (nloc == 0u) { xcd_barrier_complete(bar, b.x, nloc, nx); b.st[0] = nloc; b.st[1] = nx; }
        const unsigned old = xb_add(&bar[XB_XSUB(b.x)], 1u);
        const unsigned gen = old / nloc;
        if (old + 1u == (gen + 1u) * nloc) {
            __builtin_amdgcn_fence(__ATOMIC_RELEASE, "agent");
            asm volatile("s_waitcnt vmcnt(0)" ::: "memory");
            const unsigned og = xb_add(&bar[XB_TOP], 1u);
            const unsigned tg = og / nx;
            if (og + 1u == (tg + 1u) * nx) xb_add(&bar[XB_TOPGEN], 1u);
            else XB_SPIN(xb_ld(&bar[XB_TOPGEN]) == tg, bar);
            __builtin_amdgcn_fence(__ATOMIC_ACQUIRE, "agent");
            xb_add(&bar[XB_XGEN(b.x)], 1u);
            asm volatile("s_waitcnt vmcnt(0)" ::: "memory");
        } else {
            XB_SPIN(xb_ld(&bar[XB_XGEN(b.x)]) == gen, bar);
            __builtin_amdgcn_fence(__ATOMIC_ACQUIRE, "agent");
            asm volatile("s_waitcnt vmcnt(0)" ::: "memory");
        }
    }
    __syncthreads();
}
struct Args { const float* in[20]; float* out; unsigned char* ws; int ph_lo, ph_hi; };
typedef const __attribute__((address_space(4))) Args* KArgs;
__device__ __forceinline__ KArgs get_args() { KArgs p = (KArgs)__builtin_amdgcn_kernarg_segment_ptr(); asm volatile("" : "+s"(p)); return p; }
struct Frame {
    LAS unsigned char* lds;
    volatile LAS unsigned* MISC;
    int tid, lane, wave;
    int vcu, G;
};
#define WSP(A, T, off) ((T*)((A)->ws + (off)))
enum { I_XP = 0, I_XS, I_CP, I_CS, I_WADA, I_BADA, I_GMIX, I_WIN, I_DECF, I_DECB, I_GNG, I_WPOOL, I_PSCALE, I_WOUT, I_GFFN, I_WUP, I_CONVW, I_CONVB, I_WDOWN, I_GFINAL };

__device__ __forceinline__ float wave_sum(float v) {
#pragma unroll
    for (int o = 1; o < 64; o <<= 1) v += __shfl_xor(v, o);
    return v;
}
__device__ __forceinline__ int dst_row_in(int n) {
    if (n < 1024) { const int d = n & 63, nn = d >> 5, i = (d & 31) >> 2, j = d & 3; return (n & ~63) + 8 * i + 4 * nn + j; }
    if (n < 2048) return n;
    if (n < 3072) { const int j = n - 2048; return 2048 + 256 * (j >> 7) + (j & 127); }
    if (n < 3584) return 4096 + (n - 3072);
    if (n < 4608) { const int j = n - 3584; return 2048 + 256 * (j >> 7) + 128 + (j & 127); }
    return 4608 + (n - 4608);
}
__device__ __forceinline__ int dst_row_up(int n) {
    const int lin = n >= DFF ? 1 : 0, f = n - lin * DFF; return 256 * (f >> 7) + 128 * lin + (f & 127);
}
template <int MODE>
__device__ __forceinline__ void p0_transpose_item(const float* W, int K, int N, bf16* WT, LAS float* scr, int item, int lane) {
    const int nblk = N / 32, kb = item / nblk, nb = item % nblk, k0 = 64 * kb, n0 = 32 * nb;
#pragma unroll 16
    for (int i = 0; i < 32; ++i) { const int kk = 2 * i + (lane >> 5); scr[kk * 33 + (lane & 31)] = W[(size_t)(k0 + kk) * N + n0 + (lane & 31)]; }
    LDS_WAIT(); asm volatile("" ::: "memory");
    const int c = lane & 7;
#pragma unroll
    for (int j = 0; j < 4; ++j) { const int n = (lane >> 3) + 8 * j; const LAS float* s = scr + (8 * c) * 33 + n;
        v4u o; o.x = pk2(s[0 * 33], s[1 * 33]); o.y = pk2(s[2 * 33], s[3 * 33]); o.z = pk2(s[4 * 33], s[5 * 33]); o.w = pk2(s[6 * 33], s[7 * 33]);
        const int nr = n0 + n; const int dr = MODE == 1 ? dst_row_in(nr) : (MODE == 2 ? dst_row_up(nr) : nr);
        *(GAS v4u*)(WT + (size_t)dr * K + k0 + 8 * c) = o; }
    LDS_WAIT(); asm volatile("" ::: "memory");
}
__device__ __forceinline__ float lg2_decay(float x) { return (float)(-log1p(exp(-(double)x)) * 1.4426950408889634); }
__device__ __forceinline__ void p0_prologue(Frame& F) {
    const KArgs A = get_args();
    {
        LAS float* sc = (LAS float*)(F.lds);
        LAS float* red = (LAS float*)(F.lds + 49152);
        for (int i = F.tid; i < NSEQ * D; i += NWAVES * 64) { const int b = i >> 10, k = i & 1023; const float cv = b < 8 ? A->in[I_CP][b * D + k] : A->in[I_CS][(b - 8) * D + k]; sc[i] = cv * sigmoidf_(cv); }
        __syncthreads();
        for (int cg = blockIdx.x; cg < 256; cg += F.G) {
            const int col = F.tid & 31, kr = F.tid >> 5;
            float a[NSEQ];
#pragma unroll
            for (int b = 0; b < NSEQ; ++b) a[b] = 0.f;
            if (col < 24) {
                const float* wp = A->in[I_WADA] + 24 * cg + col;
                for (int k0 = kr; k0 < D; k0 += 16 * 16) {
                    float wv[16];
#pragma unroll
                    for (int j = 0; j < 16; ++j) wv[j] = wp[(size_t)(k0 + 16 * j) * 6144];
#pragma unroll
                    for (int j = 0; j < 16; ++j) {
#pragma unroll
                        for (int b = 0; b < NSEQ; ++b) a[b] += sc[b * D + k0 + 16 * j] * wv[j]; } }
#pragma unroll
                for (int b = 0; b < NSEQ; ++b) red[(kr * NSEQ + b) * 24 + col] = a[b];
            }
            __syncthreads();
            if (F.tid < NSEQ * 24) { const int b = F.tid / 24, cc = F.tid % 24; float s = A->in[I_BADA][24 * cg + cc];
#pragma unroll
                for (int r = 0; r < 16; ++r) s += red[(r * NSEQ + b) * 24 + cc];
                WSP(A, float, WS_MOD)[b * 6144 + 24 * cg + cc] = s; }
            __syncthreads();
        }
    }
    if (blockIdx.x == 0 && F.tid < 16) WSP(A, float, WS_DEC)[F.tid] = lg2_decay(F.tid < 8 ? A->in[I_DECF][F.tid] : A->in[I_DECB][F.tid - 8]);
#if !ROT_FLY
    {
        const int gt = blockIdx.x * (NWAVES * 64) + F.tid, NT = F.G * NWAVES * 64;
        for (int i = gt; i < SEQ * 32; i += NT) { const int pos = i >> 5, fi = i & 31;
            const float invf = (float)exp2(-(double)fi * (13.287712379549449 / 32.0));
            const float ang = (float)pos * invf;
            double rev = (double)ang * 0.15915494309189535; rev -= rint(rev);
            const float r = (float)(rev * 6.283185307179586);
            WSP(A, float, WS_COS)[i] = cosf(r); WSP(A, float, WS_SIN)[i] = sinf(r); }
    }
#endif
    {
        LAS float* scr = (LAS float*)(F.lds + RING_OFF + F.wave * 16384);
        const int gw = F.vcu * NWAVES + F.wave, NGW = F.G * NWAVES;
        constexpr int I_IN = (D / 64) * (NIN / 32), I_OUT = (D / 64) * (D / 32), I_UP = (D / 64) * (NUP / 32), I_DN = (DFF / 64) * (D / 32), I_PL = (128 / 64) * (256 / 32);
        constexpr int NITEMS = I_IN + I_OUT + I_UP + I_DN + 4 * I_PL;
        for (int it = gw; it < NITEMS; it += NGW) {
            int r = it;
            if (r < I_IN) { p0_transpose_item<1>(A->in[I_WIN], D, NIN, WSP(A, bf16, WS_WIN), scr, r, F.lane); continue; } r -= I_IN;
            if (r < I_OUT) { p0_transpose_item<0>(A->in[I_WOUT], D, D, WSP(A, bf16, WS_WOUT), scr, r, F.lane); continue; } r -= I_OUT;
            if (r < I_UP) { p0_transpose_item<2>(A->in[I_WUP], D, NUP, WSP(A, bf16, WS_WUP), scr, r, F.lane); continue; } r -= I_UP;
            if (r < I_DN) { p0_transpose_item<0>(A->in[I_WDOWN], DFF, D, WSP(A, bf16, WS_WDOWN), scr, r, F.lane); continue; } r -= I_DN;
            const int g = r / I_PL; r -= g * I_PL;
            p0_transpose_item<0>(A->in[I_WPOOL] + (size_t)g * 128 * 256, 128, 256, WSP(A, bf16, WS_WPOOL) + (size_t)g * 256 * 128, scr, r, F.lane);
        }
    }
}
template <int ND>
__device__ __forceinline__ void norm_rows_bf16(Frame& F_, const float* xin, bf16* d1, const float* g, const float* scl, const float* shf, int b0, bf16* outp) {
    Frame F = F_; F.lane = launder_v(F_.lane); F.wave = launder_s(F_.wave);
    const int gw = F.vcu * NWAVES + F.wave, NGW = F.G * NWAVES;
    for (int blk = gw; blk < MS / 16; blk += NGW) {
        const int r0 = blk * 16, b = b0 + (r0 >> 13);
        f32x4 ca[4], cb[4];
#pragma unroll
        for (int j = 0; j < 4; ++j) { const int col = 4 * F.lane + 256 * j; const f32x4 gv = *(const GAS f32x4*)(g + col), sv = *(const GAS f32x4*)(scl + (size_t)b * 6144 + col);
            ca[j] = gv * (sv + 1.0f); cb[j] = *(const GAS f32x4*)(shf + (size_t)b * 6144 + col); }
        const GAS f32x4* xr = (const GAS f32x4*)(xin + (size_t)r0 * D) + F.lane;
        GAS v2u* dr = (GAS v2u*)(d1 + (size_t)r0 * D) + F.lane;
        f32x4 v[4], vn[4], vm[4]; v2u e[4], en[4], em[4];
#pragma unroll
        for (int j = 0; j < 4; ++j) { v[j] = __builtin_nontemporal_load(xr + 64 * j); vn[j] = __builtin_nontemporal_load(xr + 256 + 64 * j); if (ND) { e[j] = __builtin_nontemporal_load(dr + 64 * j); en[j] = __builtin_nontemporal_load(dr + 256 + 64 * j); } }
        for (int rr = 0; rr < 16; ++rr) {
            if (rr + 2 < 16) {
#pragma unroll
                for (int j = 0; j < 4; ++j) { vm[j] = __builtin_nontemporal_load(xr + (rr + 2) * 256 + 64 * j); if (ND) em[j] = __builtin_nontemporal_load(dr + (rr + 2) * 256 + 64 * j); } }
            float s2 = 0.f;
#pragma unroll
            for (int j = 0; j < 4; ++j) { if (ND) { v[j] += (f32x4){bflo(e[j].x), bfhi(e[j].x), bflo(e[j].y), bfhi(e[j].y)};
                    v2u xw; xw.x = pk2(v[j].x, v[j].y); xw.y = pk2(v[j].z, v[j].w); __builtin_nontemporal_store(xw, dr + rr * 256 + 64 * j);
                    v[j] = (f32x4){bflo(xw.x), bfhi(xw.x), bflo(xw.y), bfhi(xw.y)}; }
                s2 += (v[j].x * v[j].x + v[j].y * v[j].y) + (v[j].z * v[j].z + v[j].w * v[j].w); }
            const float rstd = __builtin_amdgcn_rsqf(wave_sum(s2) * (1.f / D) + EPS);
            GAS v2u* o8 = (GAS v2u*)(outp + (size_t)(r0 + rr) * D) + F.lane;
#pragma unroll
            for (int j = 0; j < 4; ++j) { const f32x4 y = v[j] * rstd * ca[j] + cb[j]; v2u w; w.x = pk2(y.x, y.y); w.y = pk2(y.z, y.w); o8[64 * j] = w; }
#pragma unroll
            for (int j = 0; j < 4; ++j) { v[j] = vn[j]; vn[j] = vm[j]; if (ND) { e[j] = en[j]; en[j] = em[j]; } }
        }
    }
}
__device__ __forceinline__ void final_norm_rows(Frame& F_, const bf16* x1, const bf16* d2, float* yout, const float* g) {
    Frame F = F_; F.lane = launder_v(F_.lane); F.wave = launder_s(F_.wave);
    const int gw = F.vcu * NWAVES + F.wave, NGW = F.G * NWAVES;
    f32x4 cg[4];
#pragma unroll
    for (int j = 0; j < 4; ++j) cg[j] = *(const GAS f32x4*)(g + 4 * F.lane + 256 * j);
    for (int blk = gw; blk < MS / 16; blk += NGW) {
        const GAS v2u* dr1 = (const GAS v2u*)(x1 + (size_t)(blk * 16) * D) + F.lane;
        const GAS v2u* dr2 = (const GAS v2u*)(d2 + (size_t)(blk * 16) * D) + F.lane;
        GAS f32x4* yr = (GAS f32x4*)(yout + (size_t)(blk * 16) * D) + F.lane;
        v2u e1[4], e1n[4], e1m[4], e2[4], e2n[4], e2m[4];
#pragma unroll
        for (int j = 0; j < 4; ++j) { e1[j] = __builtin_nontemporal_load(dr1 + 64 * j); e2[j] = __builtin_nontemporal_load(dr2 + 64 * j); e1n[j] = __builtin_nontemporal_load(dr1 + 256 + 64 * j); e2n[j] = __builtin_nontemporal_load(dr2 + 256 + 64 * j); }
        for (int rr = 0; rr < 16; ++rr) {
            if (rr + 2 < 16) {
#pragma unroll
                for (int j = 0; j < 4; ++j) { e1m[j] = __builtin_nontemporal_load(dr1 + (rr + 2) * 256 + 64 * j); e2m[j] = __builtin_nontemporal_load(dr2 + (rr + 2) * 256 + 64 * j); } }
            f32x4 v[4]; float s2 = 0.f;
#pragma unroll
            for (int j = 0; j < 4; ++j) { v[j] = (f32x4){bflo(e1[j].x), bfhi(e1[j].x), bflo(e1[j].y), bfhi(e1[j].y)} + (f32x4){bflo(e2[j].x), bfhi(e2[j].x), bflo(e2[j].y), bfhi(e2[j].y)};
                s2 += (v[j].x * v[j].x + v[j].y * v[j].y) + (v[j].z * v[j].z + v[j].w * v[j].w); }
            const float rstd = __builtin_amdgcn_rsqf(wave_sum(s2) * (1.f / D) + EPS);
#pragma unroll
            for (int j = 0; j < 4; ++j) __builtin_nontemporal_store(v[j] * rstd * cg[j], (f32x4*)(yr + rr * 256 + 64 * j));
#pragma unroll
            for (int j = 0; j < 4; ++j) { e1[j] = e1n[j]; e1n[j] = e1m[j]; e2[j] = e2n[j]; e2n[j] = e2m[j]; }
        }
    }
}
constexpr int C1_V = 0, C1_KF = 36864, C1_KB = 36864 + 20480, C1_SCR = 36864 + 2 * 20480;
__device__ __forceinline__ void c1_phase(Frame& F_) {
    const KArgs A = get_args();
    LAS unsigned char* L = F_.lds;
    const int tid0 = launder_v(F_.tid), w = launder_s(F_.wave);
    const bf16* PROJ = WSP(A, bf16, WS_PROJ);
    int u = F_.vcu; if (u >= NUNIT) return;
    v4u sv[4], sk[2];
#define C1_CONSTS(t) const int tid = launder_v(t), lane = tid & 63, g = lane >> 4, q = (lane & 15) >> 2, p = lane & 3, l15 = lane & 15; \
    unsigned offK[2], offV[4]; \
    _Pragma("unroll") for (int i = 0; i < 2; ++i) { const int id = tid + 512 * i, rr = id >> 3, cc = id & 7; offK[i] = (unsigned)(rr * NPJ + cc * 8) * 2u; } \
    _Pragma("unroll") for (int i = 0; i < 4; ++i) { const int id = tid + 512 * i, rr = id >> 4, cc = id & 15; offV[i] = (unsigned)(rr * NPJ + cc * 8) * 2u; } (void)q; (void)p; (void)l15; (void)g
#define LDG(T, base, off) __builtin_nontemporal_load((const GAS T*)((const GAS char*)(base) + (unsigned)launder_v((int)(off))))
#define C1_LOAD(uu) do { const int sq_ = (uu) >> 9, c_ = ((uu) >> 3) & 63, h_ = (uu) & 7; const bf16* pr_ = PROJ + (size_t)(sq_ * SEQ + c_ * 128) * NPJ; \
        _Pragma("unroll") for (int i = 0; i < 4; ++i) sv[i] = LDG(v4u, pr_ + COL_V + h_ * 128, offV[i]); \
        _Pragma("unroll") for (int i = 0; i < 2; ++i) sk[i] = LDG(v4u, pr_ + COL_K + h_ * 64, offK[i]); } while (0)
#define C1_WRITE(uu) do { const float l2f = WSP(A, float, WS_DEC)[(uu) & 7], l2b = WSP(A, float, WS_DEC)[8 + ((uu) & 7)]; \
        _Pragma("unroll") for (int i = 0; i < 4; ++i) { const int id = tid + 512 * i, rr = id >> 4, cc = id & 15; *(LAS v4u*)(L + C1_V + rr * 288 + cc * 16) = sv[i]; } \
        _Pragma("unroll") for (int i = 0; i < 2; ++i) { const int id = tid + 512 * i, rr = id >> 3, cc = id & 7; const v4u kv = sk[i]; \
            const float wf = __builtin_amdgcn_exp2f(l2f * (float)(127 - rr)), wb = __builtin_amdgcn_exp2f(l2b * (float)rr); v4u kf, kb; \
            kf.x = pk2(bflo(kv.x) * wf, bfhi(kv.x) * wf); kf.y = pk2(bflo(kv.y) * wf, bfhi(kv.y) * wf); kf.z = pk2(bflo(kv.z) * wf, bfhi(kv.z) * wf); kf.w = pk2(bflo(kv.w) * wf, bfhi(kv.w) * wf); \
            kb.x = pk2(bflo(kv.x) * wb, bfhi(kv.x) * wb); kb.y = pk2(bflo(kv.y) * wb, bfhi(kv.y) * wb); kb.z = pk2(bflo(kv.z) * wb, bfhi(kv.z) * wb); kb.w = pk2(bflo(kv.w) * wb, bfhi(kv.w) * wb); \
            *(LAS v4u*)(L + C1_KF + rr * 160 + cc * 16) = kf; *(LAS v4u*)(L + C1_KB + rr * 160 + cc * 16) = kb; } } while (0)
    { C1_CONSTS(tid0); C1_LOAD(u); C1_WRITE(u); }
    __syncthreads();
    for (;;) {
        C1_CONSTS(tid0);
        const int un = u + F_.G; const bool has_next = un < NUNIT;
        if (has_next) C1_LOAD(un);
        asm volatile("" ::: "memory");
        f32x4 af[4], ab[4];
#pragma unroll
        for (int i = 0; i < 4; ++i) { af[i] = (f32x4){0.f, 0.f, 0.f, 0.f}; ab[i] = (f32x4){0.f, 0.f, 0.f, 0.f}; }
#pragma unroll
        for (int kb = 0; kb < 4; ++kb) {
            const int rowa = 32 * kb + 4 * g + q;
            const s16x4 v0 = __builtin_amdgcn_ds_read_tr16_b64_v4i16((LAS s16x4*)(L + C1_V + rowa * 288 + (16 * w + 4 * p) * 2));
            const s16x4 v1 = __builtin_amdgcn_ds_read_tr16_b64_v4i16((LAS s16x4*)(L + C1_V + (rowa + 16) * 288 + (16 * w + 4 * p) * 2));
            const bf16x8 vf = (bf16x8){v0.x, v0.y, v0.z, v0.w, v1.x, v1.y, v1.z, v1.w};
            s16x4 f0[4], f1[4], b0[4], b1[4];
#pragma unroll
            for (int db = 0; db < 4; ++db) {
                f0[db] = __builtin_amdgcn_ds_read_tr16_b64_v4i16((LAS s16x4*)(L + C1_KF + rowa * 160 + (16 * db + 4 * p) * 2));
                f1[db] = __builtin_amdgcn_ds_read_tr16_b64_v4i16((LAS s16x4*)(L + C1_KF + (rowa + 16) * 160 + (16 * db + 4 * p) * 2));
                b0[db] = __builtin_amdgcn_ds_read_tr16_b64_v4i16((LAS s16x4*)(L + C1_KB + rowa * 160 + (16 * db + 4 * p) * 2));
                b1[db] = __builtin_amdgcn_ds_read_tr16_b64_v4i16((LAS s16x4*)(L + C1_KB + (rowa + 16) * 160 + (16 * db + 4 * p) * 2)); }
            __builtin_amdgcn_sched_barrier(0);
#pragma unroll
            for (int db = 0; db < 4; ++db) {
                af[db] = __builtin_amdgcn_mfma_f32_16x16x32_bf16((bf16x8){f0[db].x, f0[db].y, f0[db].z, f0[db].w, f1[db].x, f1[db].y, f1[db].z, f1[db].w}, vf, af[db], 0, 0, 0);
                ab[db] = __builtin_amdgcn_mfma_f32_16x16x32_bf16((bf16x8){b0[db].x, b0[db].y, b0[db].z, b0[db].w, b1[db].x, b1[db].y, b1[db].z, b1[db].w}, vf, ab[db], 0, 0, 0);
            }
        }
        { LAS unsigned char* S = L + C1_SCR + w * 4096;
#pragma unroll
          for (int db = 0; db < 4; ++db) { v2u o; o.x = pk2(af[db].x, af[db].y); o.y = pk2(af[db].z, af[db].w);
              const int ch = (2 * db + (g >> 1)) ^ (l15 & 7), sub = (g & 1) * 8;
              *(LAS v2u*)(S + l15 * 128 + ch * 16 + sub) = o;
              o.x = pk2(ab[db].x, ab[db].y); o.y = pk2(ab[db].z, ab[db].w); *(LAS v2u*)(S + 2048 + l15 * 128 + ch * 16 + sub) = o; }
          bf16* lo = WSP(A, bf16, WS_LST) + (size_t)u * (2 * 128 * 64) + (16 * w) * 64;
#pragma unroll
          for (int i = 0; i < 4; ++i) { const int id = lane + 64 * i, dir = id >> 7, rr = (id >> 3) & 15, cc = id & 7;
              const v4u v = *(const LAS v4u*)(S + dir * 2048 + rr * 128 + ((cc ^ (rr & 7)) * 16));
              *(GAS v4u*)(lo + dir * (128 * 64) + rr * 64 + cc * 8) = v; } }
        __syncthreads();
        if (!has_next) break;
        C1_WRITE(un); u = un;
        __syncthreads();
    }
#undef C1_CONSTS
#undef C1_LOAD
#undef C1_WRITE
#undef LDG
}
__device__ __forceinline__ void c2_scan(Frame& F_) {
    const KArgs A = get_args();
    Frame F = F_; F.tid = launder_v(F_.tid);
    const int NT = F.G * NWAVES * 64;
    for (int gid = blockIdx.x * (NWAVES * 64) + F.tid; gid < SLAB_SEQ * 8 * 2 * 2048; gid += NT) {
        const int e4 = gid & 2047, dir = (gid >> 11) & 1, h = (gid >> 12) & 7, sq = gid >> 15;
        const float Gd = __builtin_amdgcn_exp2f(128.0f * WSP(A, float, WS_DEC)[dir * 8 + h]);
        const size_t ustride = (size_t)8 * (2 * 128 * 64);
        const size_t base = ((size_t)(sq * 512 + h) * 2 + dir) * (128 * 64) + (size_t)e4 * 4;
        const bf16* lp = WSP(A, bf16, WS_LST) + base; bf16* sp = WSP(A, bf16, WS_SST) + base;
        f32x4 S = (f32x4){0.f, 0.f, 0.f, 0.f};
        for (int i0 = 0; i0 < 64; i0 += 16) {
            v2u l[16];
#pragma unroll
            for (int j = 0; j < 16; ++j) { const int c = dir ? 63 - (i0 + j) : i0 + j; l[j] = __builtin_nontemporal_load((const GAS v2u*)(lp + c * ustride)); }
#pragma unroll
            for (int j = 0; j < 16; ++j) { const int c = dir ? 63 - (i0 + j) : i0 + j;
                v2u o; o.x = pk2(S.x, S.y); o.y = pk2(S.z, S.w); *(GAS v2u*)(sp + c * ustride) = o;
                S = S * Gd + (f32x4){bflo(l[j].x), bfhi(l[j].x), bflo(l[j].y), bfhi(l[j].y)}; }
        }
    }
}
constexpr int PL_WP = 0, PL_WAVE = 65536;
__device__ __forceinline__ void pool_units(Frame& F_) {
    const KArgs A = get_args();
    const int tid = launder_v(F_.tid), lane = tid & 63, w = launder_s(F_.wave);
    LAS unsigned char* L = F_.lds;
    const int g = lane >> 4, l15 = lane & 15;
    const bf16* PROJ = WSP(A, bf16, WS_PROJ); bf16* BB = WSP(A, bf16, WS_BB);
    const int gi = F_.vcu & 3, nb_gi = (F_.G - gi + 3) >> 2;
    if (F_.G < 4) return;
    { const bf16* wp = WSP(A, bf16, WS_WPOOL) + (size_t)gi * 256 * 128;
#pragma unroll
      for (int i = 0; i < 8; ++i) { const int id = tid + 512 * i, rr = id >> 4, cc = id & 15;
          const v4u wv = *(const GAS v4u*)(wp + rr * 128 + cc * 8); const float ps = A->in[I_PSCALE][gi * 256 + rr];
          v4u o; o.x = pk2(bflo(wv.x) * ps, bfhi(wv.x) * ps); o.y = pk2(bflo(wv.y) * ps, bfhi(wv.y) * ps); o.z = pk2(bflo(wv.z) * ps, bfhi(wv.z) * ps); o.w = pk2(bflo(wv.w) * ps, bfhi(wv.w) * ps);
          *(LAS v4u*)(L + PL_WP + rr * 256 + ((cc ^ (rr & 15)) * 16)) = o; } }
    __syncthreads();
    LAS unsigned char* W = L + PL_WAVE + w * 8192;
    const int half = 1 << gi;
    const int wv0 = (F_.vcu >> 2) * NWAVES + w, wvn = nb_gi * NWAVES;
    v4u st[8];
#define PL_LOAD(uu) do { const int sq_ = (uu) >> 9, rb_ = (uu) & 511; \
        _Pragma("unroll") for (int i = 0; i < 8; ++i) { const int id = lane + 64 * i, rr = id >> 4, cc = id & 15, pos = rb_ * 16 - 8 + rr; \
            st[i] = (v4u){0u, 0u, 0u, 0u}; if (pos >= 0 && pos < SEQ) st[i] = __builtin_nontemporal_load((const GAS v4u*)(PROJ + (size_t)(sq_ * SEQ + pos) * NPJ + COL_P + gi * 128 + cc * 8)); } } while (0)
    int uu = wv0;
    if (uu < SLAB_SEQ * 512) PL_LOAD(uu);
    for (; uu < SLAB_SEQ * 512; uu += wvn) {
        const int sq = uu >> 9, rb = uu & 511, row0 = sq * SEQ + rb * 16;
#pragma unroll
        for (int i = 0; i < 8; ++i) { const int id = lane + 64 * i, rr = id >> 4, cc = id & 15; *(LAS v4u*)(W + rr * 256 + cc * 16) = st[i]; }
        const int un = uu + wvn;
        if (un < SLAB_SEQ * 512) PL_LOAD(un);
        asm volatile("" ::: "memory");
        const LAS unsigned* pr = (const LAS unsigned*)W + lane;
        float s0 = 0.f, s1 = 0.f;
        for (int k = 8 - half; k < 8 + half; ++k) { const unsigned x = pr[k * 64]; s0 += bflo(x); s1 += bfhi(x); }
        unsigned pooled[16];
#pragma unroll
        for (int n = 0; n < 16; ++n) { const int pos = rb * 16 + n; const int lo = pos - half < 0 ? 0 : pos - half, hi = pos + half > SEQ ? SEQ : pos + half;
            const float rc = __builtin_amdgcn_rcpf((float)(hi - lo)); const unsigned x = pr[(n + 8) * 64];
            pooled[n] = pk2(s0 * rc - bflo(x), s1 * rc - bfhi(x));
            const unsigned xa = pr[(n + 8 + half) * 64], xs = pr[(n + 8 - half) * 64]; s0 += bflo(xa) - bflo(xs); s1 += bfhi(xa) - bfhi(xs); }
#pragma unroll
        for (int n = 0; n < 16; ++n) *(LAS unsigned*)(W + n * 256 + (((lane >> 2) ^ n) * 16) + (lane & 3) * 4) = pooled[n];
        f32x4 acc[16];
#pragma unroll
        for (int i = 0; i < 16; ++i) acc[i] = (f32x4){0.f, 0.f, 0.f, 0.f};
#pragma unroll
        for (int kb = 0; kb < 4; ++kb) {
            const bf16x8 a = *(const LAS bf16x8*)(W + l15 * 256 + (((4 * kb + g) ^ l15) * 16));
            for (int h8 = 0; h8 < 2; ++h8) { bf16x8 b[8];
#pragma unroll
                for (int nb = 0; nb < 8; ++nb) b[nb] = *(const LAS bf16x8*)(L + PL_WP + (16 * (8 * h8 + nb) + l15) * 256 + (((4 * kb + g) ^ l15) * 16));
                __builtin_amdgcn_sched_barrier(0);
#pragma unroll
                for (int nb = 0; nb < 8; ++nb) acc[8 * h8 + nb] = __builtin_amdgcn_mfma_f32_16x16x32_bf16(b[nb], a, acc[8 * h8 + nb], 0, 0, 0); }
        }
#pragma unroll
        for (int nb = 0; nb < 16; ++nb) { const f32x4 o = acc[nb];
            v2u ow; ow.x = pk2(o.x, o.y); ow.y = pk2(o.z, o.w); *(LAS v2u*)(W + l15 * 512 + (((2 * nb + (g >> 1)) ^ l15) * 16) + (g & 1) * 8) = ow; }
        bf16* orow = BB + (size_t)row0 * D + gi * 256;
#pragma unroll
        for (int i = 0; i < 8; ++i) { const int id = lane + 64 * i, rr = id >> 5, cc = id & 31;
            const v4u v = *(const LAS v4u*)(W + rr * 512 + ((cc ^ rr) * 16));
            *(GAS v4u*)(orow + (size_t)rr * D + cc * 8) = v; }
    }
#undef PL_LOAD
    __syncthreads();
}
constexpr int C3_K = 0, C3_V = 18432, C3_SF = 18432 + 36864, C3_SB = C3_SF + 18432, C3_GAIN = C3_SB + 18432, C3_Y = C3_GAIN + 512;
__device__ __forceinline__ float fast_sigmoid(float x) { return __builtin_amdgcn_rcpf(1.0f + __builtin_amdgcn_exp2f(-1.4426950408889634f * x)); }
__device__ __forceinline__ void c3_phase(Frame& F_, int mode) {
    const KArgs A = get_args();
    const int tid0 = launder_v(F_.tid), w = launder_s(F_.wave);
    LAS unsigned char* L = F_.lds;
    const bf16* PROJ = WSP(A, bf16, WS_PROJ); const bf16* SST = WSP(A, bf16, WS_SST); const bf16* BB = WSP(A, bf16, WS_BB); bf16* MERGED = WSP(A, bf16, WS_MERGED);
    int u = F_.vcu; if (u >= NUNIT) return;
    v4u sk[2], sv[4], ssf[2], ssb[2], qn[2], qc[2];
#define C3_CONSTS(t) const int tid = launder_v(t), lane = tid & 63, g = lane >> 4, q = (lane & 15) >> 2, p = lane & 3, l15 = lane & 15, n = 16 * w + l15; \
    unsigned offK[2], offS[2], offV[4]; \
    _Pragma("unroll") for (int i = 0; i < 2; ++i) { const int id = tid + 512 * i, rr = id >> 3, cc = id & 7; offK[i] = (unsigned)(rr * NPJ + cc * 8) * 2u; offS[i] = (unsigned)(rr * 64 + cc * 8) * 2u; } \
    _Pragma("unroll") for (int i = 0; i < 4; ++i) { const int id = tid + 512 * i, rr = id >> 4, cc = id & 15; offV[i] = (unsigned)(rr * NPJ + cc * 8) * 2u; } \
    const unsigned offQ = (unsigned)(n * NPJ + 8 * g) * 2u, offG = (unsigned)(n * NPJ + 4 * g) * 2u, offO = (unsigned)(n * D + 4 * g) * 2u; (void)q; (void)p; (void)offG; (void)offO; (void)offQ
#define LDG(T, base, off) __builtin_nontemporal_load((const GAS T*)((const GAS char*)(base) + (unsigned)launder_v((int)(off))))
#define C3_LOAD(uu) do { const int sq_ = (uu) >> 9, c_ = ((uu) >> 3) & 63, h_ = (uu) & 7; const bf16* pr_ = PROJ + (size_t)(sq_ * SEQ + c_ * 128) * NPJ; \
        const bf16* bk_ = pr_ + COL_K + h_ * 64; const bf16* bv_ = pr_ + COL_V + h_ * 128; const bf16* bq_ = pr_ + COL_Q + h_ * 64; const bf16* bs_ = SST + (size_t)(uu) * (2 * 128 * 64); \
        _Pragma("unroll") for (int i = 0; i < 2; ++i) { sk[i] = LDG(v4u, bk_, offK[i]); ssf[i] = LDG(v4u, bs_, offS[i]); ssb[i] = LDG(v4u, bs_ + 128 * 64, offS[i]); } \
        _Pragma("unroll") for (int i = 0; i < 4; ++i) sv[i] = LDG(v4u, bv_, offV[i]); \
        _Pragma("unroll") for (int kb = 0; kb < 2; ++kb) qn[kb] = LDG(v4u, bq_ + 32 * kb, offQ); } while (0)
#define C3_WRITE() do { \
        _Pragma("unroll") for (int i = 0; i < 2; ++i) { const int id = tid + 512 * i, rr = id >> 3, cc = id & 7; \
            *(LAS v4u*)(L + C3_K + rr * 144 + cc * 16) = sk[i]; *(LAS v4u*)(L + C3_SF + rr * 144 + cc * 16) = ssf[i]; *(LAS v4u*)(L + C3_SB + rr * 144 + cc * 16) = ssb[i]; } \
        _Pragma("unroll") for (int i = 0; i < 4; ++i) { const int id = tid + 512 * i, rr = id >> 4, cc = id & 15; *(LAS v4u*)(L + C3_V + rr * 288 + cc * 16) = sv[i]; } \
        qc[0] = qn[0]; qc[1] = qn[1]; } while (0)
    int cur_h = u & 7;
    { C3_CONSTS(tid0);
      C3_LOAD(u);
      if (tid < 128) ((LAS float*)(L + C3_GAIN))[tid] = A->in[I_GNG][cur_h * 128 + tid];
      C3_WRITE(); }
    __syncthreads();
    for (;;) {
        C3_CONSTS(tid0);
        const int un = u + F_.G; const bool has_next = un < NUNIT;
        const int sq = u >> 9, c = (u >> 3) & 63, h = u & 7, r0 = sq * SEQ + c * 128;
        if (has_next) C3_LOAD(un);
        const bf16* grow = PROJ + (size_t)r0 * NPJ + h * 128;
        const bf16* brow = BB + (size_t)r0 * D + h * 128;
        const float l2f = WSP(A, float, WS_DEC)[h], l2b = WSP(A, float, WS_DEC)[8 + h];
        asm volatile("" ::: "memory");
        v4u gga[4], ggb[4], gbb[4];
        const unsigned offG2 = (unsigned)((tid >> 4) * NPJ + (tid & 15) * 8) * 2u, offO2 = (unsigned)((tid >> 4) * D + (tid & 15) * 8) * 2u;
        if (!(mode & 1))
#pragma unroll
        for (int j = 0; j < 4; ++j) { gga[j] = LDG(v4u, grow + COL_A + (size_t)32 * j * NPJ, offG2); ggb[j] = LDG(v4u, grow + COL_B + (size_t)32 * j * NPJ, offG2); gbb[j] = LDG(v4u, brow + (size_t)32 * j * D, offO2); }
        asm volatile("" ::: "memory");
        f32x4 sc[8];
#pragma unroll
        for (int kb = 0; kb < 2; ++kb) { bf16x8 kf[8];
#pragma unroll
            for (int mb = 0; mb < 8; ++mb) kf[mb] = *(const LAS bf16x8*)(L + C3_K + (16 * mb + l15) * 144 + (32 * kb + 8 * g) * 2);
            __builtin_amdgcn_sched_barrier(0);
#pragma unroll
            for (int mb = 0; mb < 8; ++mb) sc[mb] = __builtin_amdgcn_mfma_f32_16x16x32_bf16(kf[mb], __builtin_bit_cast(bf16x8, qc[kb]), kb == 0 ? (f32x4){0.f, 0.f, 0.f, 0.f} : sc[mb], 0, 0, 0); }
        bf16x8 pf[4];
#pragma unroll
        for (int kb = 0; kb < 4; ++kb) { float v[8];
#pragma unroll
            for (int t = 0; t < 2; ++t)
#pragma unroll
                for (int e = 0; e < 4; ++e) { const int m = 32 * kb + 16 * t + 4 * g + e, df = n - m;
                    const float dec = __builtin_amdgcn_exp2f(df >= 0 ? l2f * (float)df : l2b * (float)(-df));
                    v[4 * t + e] = sc[2 * kb + t][e] * dec; }
            v4u pw; pw.x = pk2(v[0], v[1]); pw.y = pk2(v[2], v[3]); pw.z = pk2(v[4], v[5]); pw.w = pk2(v[6], v[7]);
            pf[kb] = __builtin_bit_cast(bf16x8, pw); }
        f32x4 ao[8];
#pragma unroll
        for (int i = 0; i < 8; ++i) ao[i] = (f32x4){0.f, 0.f, 0.f, 0.f};
#pragma unroll
        for (int kb = 0; kb < 4; ++kb) { const int rowa = 32 * kb + 4 * g + q;
            s16x4 v0[8], v1[8];
#pragma unroll
            for (int nb = 0; nb < 8; ++nb) {
                v0[nb] = __builtin_amdgcn_ds_read_tr16_b64_v4i16((LAS s16x4*)(L + C3_V + rowa * 288 + (16 * nb + 4 * p) * 2));
                v1[nb] = __builtin_amdgcn_ds_read_tr16_b64_v4i16((LAS s16x4*)(L + C3_V + (rowa + 16) * 288 + (16 * nb + 4 * p) * 2)); }
            __builtin_amdgcn_sched_barrier(0);
#pragma unroll
            for (int nb = 0; nb < 8; ++nb)
                ao[nb] = __builtin_amdgcn_mfma_f32_16x16x32_bf16((bf16x8){v0[nb].x, v0[nb].y, v0[nb].z, v0[nb].w, v1[nb].x, v1[nb].y, v1[nb].z, v1[nb].w}, pf[kb], ao[nb], 0, 0, 0); }
        { const float dqf = __builtin_amdgcn_exp2f(l2f * (float)(n + 1)), dqb = __builtin_amdgcn_exp2f(l2b * (float)(128 - n));
#pragma unroll
          for (int kb = 0; kb < 2; ++kb) { const v4u qv = qc[kb]; v4u qf, qb;
              qf.x = pk2(bflo(qv.x) * dqf, bfhi(qv.x) * dqf); qf.y = pk2(bflo(qv.y) * dqf, bfhi(qv.y) * dqf); qf.z = pk2(bflo(qv.z) * dqf, bfhi(qv.z) * dqf); qf.w = pk2(bflo(qv.w) * dqf, bfhi(qv.w) * dqf);
              qb.x = pk2(bflo(qv.x) * dqb, bfhi(qv.x) * dqb); qb.y = pk2(bflo(qv.y) * dqb, bfhi(qv.y) * dqb); qb.z = pk2(bflo(qv.z) * dqb, bfhi(qv.z) * dqb); qb.w = pk2(bflo(qv.w) * dqb, bfhi(qv.w) * dqb);
              { bf16x8 sf[8];
#pragma unroll
                for (int nb = 0; nb < 8; ++nb) sf[nb] = *(const LAS bf16x8*)(L + C3_SF + (16 * nb + l15) * 144 + (32 * kb + 8 * g) * 2);
                __builtin_amdgcn_sched_barrier(0);
#pragma unroll
                for (int nb = 0; nb < 8; ++nb) ao[nb] = __builtin_amdgcn_mfma_f32_16x16x32_bf16(sf[nb], __builtin_bit_cast(bf16x8, qf), ao[nb], 0, 0, 0); }
              { bf16x8 sb[8];
#pragma unroll
                for (int nb = 0; nb < 8; ++nb) sb[nb] = *(const LAS bf16x8*)(L + C3_SB + (16 * nb + l15) * 144 + (32 * kb + 8 * g) * 2);
                __builtin_amdgcn_sched_barrier(0);
#pragma unroll
                for (int nb = 0; nb < 8; ++nb) ao[nb] = __builtin_amdgcn_mfma_f32_16x16x32_bf16(sb[nb], __builtin_bit_cast(bf16x8, qb), ao[nb], 0, 0, 0); } } }
        float s1 = 0.f;
#pragma unroll
        for (int nb = 0; nb < 8; ++nb) s1 += (ao[nb].x + ao[nb].y) + (ao[nb].z + ao[nb].w);
        s1 += __shfl_xor(s1, 16); s1 += __shfl_xor(s1, 32);
        const float mu = s1 * (1.f / 128.f); float s2 = 0.f;
#pragma unroll
        for (int nb = 0; nb < 8; ++nb) { const f32x4 dd = ao[nb] - mu; s2 += (dd.x * dd.x + dd.y * dd.y) + (dd.z * dd.z + dd.w * dd.w); }
        s2 += __shfl_xor(s2, 16); s2 += __shfl_xor(s2, 32);
        const float rstd = __builtin_amdgcn_rsqf(s2 * (1.f / 128.f) + EPS);
#pragma unroll
        for (int nb = 0; nb < 8; ++nb) { const f32x4 gain = *(const LAS f32x4*)(L + C3_GAIN + (16 * nb + 4 * g) * 4); const f32x4 y = (ao[nb] - mu) * rstd * gain;
            v2u yw; yw.x = pk2(y.x, y.y); yw.y = pk2(y.z, y.w); *(LAS v2u*)(L + C3_Y + n * 272 + (16 * nb + 4 * g) * 2) = yw; }
        __syncthreads();
        bf16* orow = MERGED + (size_t)r0 * D + h * 128;
        if (!(mode & 1))
#pragma unroll
        for (int j = 0; j < 4; ++j) {
            const v4u yv = *(const LAS v4u*)(L + C3_Y + ((tid >> 4) + 32 * j) * 272 + (tid & 15) * 16);
            const unsigned yu[4] = {yv.x, yv.y, yv.z, yv.w}, au[4] = {gga[j].x, gga[j].y, gga[j].z, gga[j].w}, bu[4] = {ggb[j].x, ggb[j].y, ggb[j].z, ggb[j].w}, pu[4] = {gbb[j].x, gbb[j].y, gbb[j].z, gbb[j].w};
            unsigned ow[4];
#pragma unroll
            for (int e = 0; e < 4; ++e) ow[e] = pk2(bflo(au[e]) * bflo(yu[e]) + bflo(bu[e]) * bflo(pu[e]), bfhi(au[e]) * bfhi(yu[e]) + bfhi(bu[e]) * bfhi(pu[e]));
            *(GAS v4u*)((GAS char*)(orow + (size_t)32 * j * D) + (unsigned)launder_v((int)offO2)) = (v4u){ow[0], ow[1], ow[2], ow[3]};
        }
        if (!has_next) break;
        if ((un & 7) != cur_h) { cur_h = un & 7; if (tid < 128) ((LAS float*)(L + C3_GAIN))[tid] = A->in[I_GNG][cur_h * 128 + tid]; }
        C3_WRITE(); u = un;
        __syncthreads();
    }
#undef C3_LOAD
#undef C3_WRITE
#undef LDG
#undef C3_CONSTS
}
__device__ __forceinline__ float gelu_tanh(float x) { const float t = x * (-2.302208198f + -0.10294324f * x * x); return x * __builtin_amdgcn_rcpf(1.0f + __builtin_amdgcn_exp2f(t)); }
__device__ __forceinline__ void conv_gelu_phase(Frame& F_) {
    const KArgs A = get_args();
    Frame F = F_; F.tid = launder_v(F_.tid);
    const int NT = F.G * NWAVES * 64;
    const bf16* UP = WSP(A, bf16, WS_PROJ);
    constexpr int RUN = 8, NTASK = (MS / RUN) * (DFF / 8);
    LAS float* CW = (LAS float*)F.lds;
    for (int i = F.tid; i < 3 * NUP / 4; i += NWAVES * 64) *(LAS f32x4*)(CW + 4 * i) = *(const GAS f32x4*)(A->in[I_CONVW] + 4 * i);
    for (int i = F.tid; i < NUP / 4; i += NWAVES * 64) *(LAS f32x4*)(CW + 3 * NUP + 4 * i) = *(const GAS f32x4*)(A->in[I_CONVB] + 4 * i);
    __syncthreads();
    const v4u z = (v4u){0u, 0u, 0u, 0u};
    v4u ra[RUN + 2], rl[RUN + 2], na[RUN + 2], nl[RUN + 2];
#define CV_LOADROW(dsta, dstl, tk, i) do { const int ck_ = (tk) % (DFF / 8), run_ = (tk) / (DFF / 8), f0_ = ck_ * 8, r0_ = run_ * RUN; \
        const bf16* base_ = UP + (size_t)r0_ * NUP + 256 * (f0_ >> 7) + (f0_ & 127); \
        const bool ok_ = ((i) == 0) ? ((r0_ & (SEQ - 1)) != 0) : (((i) == RUN + 1) ? (((r0_ + RUN) & (SEQ - 1)) != 0) : true); \
        if (ok_) { dsta[i] = *(const GAS v4u*)(base_ + (ptrdiff_t)((i) - 1) * NUP); dstl[i] = *(const GAS v4u*)(base_ + (ptrdiff_t)((i) - 1) * NUP + 128); } else { dsta[i] = z; dstl[i] = z; } } while (0)
    int task = blockIdx.x * (NWAVES * 64) + F.tid;
    if (task < NTASK) {
#pragma unroll
        for (int i = 0; i < RUN + 2; ++i) CV_LOADROW(ra, rl, task, i); }
    for (; task < NTASK; task += NT) {
        const int tn = task + NT; const bool has_next = tn < NTASK;
        const int ck = task % (DFF / 8), run = task / (DFF / 8), f0 = ck * 8, r0 = run * RUN;
        float wa[3][8], wl[3][8], ba[8], bl[8];
#pragma unroll
        for (int j = 0; j < 4; ++j) { const f32x4 a0 = *(const LAS f32x4*)(CW + j * NUP + f0), a1 = *(const LAS f32x4*)(CW + j * NUP + f0 + 4), l0 = *(const LAS f32x4*)(CW + j * NUP + DFF + f0), l1 = *(const LAS f32x4*)(CW + j * NUP + DFF + f0 + 4);
#pragma unroll
            for (int e = 0; e < 4; ++e) { if (j < 3) { wa[j][e] = a0[e]; wa[j][4 + e] = a1[e]; wl[j][e] = l0[e]; wl[j][4 + e] = l1[e]; } else { ba[e] = a0[e]; ba[4 + e] = a1[e]; bl[e] = l0[e]; bl[4 + e] = l1[e]; } } }
#pragma unroll
        for (int rr = 0; rr < RUN; ++rr) {
            const unsigned pau[4] = {ra[rr].x, ra[rr].y, ra[rr].z, ra[rr].w}, plu[4] = {rl[rr].x, rl[rr].y, rl[rr].z, rl[rr].w}, cau[4] = {ra[rr + 1].x, ra[rr + 1].y, ra[rr + 1].z, ra[rr + 1].w}, clu[4] = {rl[rr + 1].x, rl[rr + 1].y, rl[rr + 1].z, rl[rr + 1].w},
                           nau[4] = {ra[rr + 2].x, ra[rr + 2].y, ra[rr + 2].z, ra[rr + 2].w}, nlu[4] = {rl[rr + 2].x, rl[rr + 2].y, rl[rr + 2].z, rl[rr + 2].w};
            unsigned ow[4];
#pragma unroll
            for (int e2 = 0; e2 < 4; ++e2) {
                const float a0 = bflo(pau[e2]) * wa[0][2 * e2] + bflo(cau[e2]) * wa[1][2 * e2] + bflo(nau[e2]) * wa[2][2 * e2] + ba[2 * e2];
                const float a1 = bfhi(pau[e2]) * wa[0][2 * e2 + 1] + bfhi(cau[e2]) * wa[1][2 * e2 + 1] + bfhi(nau[e2]) * wa[2][2 * e2 + 1] + ba[2 * e2 + 1];
                const float l0 = bflo(plu[e2]) * wl[0][2 * e2] + bflo(clu[e2]) * wl[1][2 * e2] + bflo(nlu[e2]) * wl[2][2 * e2] + bl[2 * e2];
                const float l1 = bfhi(plu[e2]) * wl[0][2 * e2 + 1] + bfhi(clu[e2]) * wl[1][2 * e2 + 1] + bfhi(nlu[e2]) * wl[2][2 * e2 + 1] + bl[2 * e2 + 1];
                ow[e2] = pk2(gelu_tanh(a0) * l0, gelu_tanh(a1) * l1); }
            *(GAS v4u*)(WSP(A, bf16, WS_G) + (size_t)(r0 + rr) * DFF + f0) = (v4u){ow[0], ow[1], ow[2], ow[3]};
            if (has_next) CV_LOADROW(na, nl, tn, rr);
            asm volatile("" ::: "memory");
        }
        if (has_next) { CV_LOADROW(na, nl, tn, RUN); CV_LOADROW(na, nl, tn, RUN + 1); }
#pragma unroll
        for (int i = 0; i < RUN + 2; ++i) { ra[i] = na[i]; rl[i] = nl[i]; }
    }
#undef CV_LOADROW
    __syncthreads();
}

__device__ __forceinline__ void conv_fixup_phase(Frame& F_) {
    const KArgs A = get_args();
    const int tid = launder_v(F_.tid);
    const int NT = F_.G * NWAVES * 64;
    const bf16* EDGE = WSP(A, bf16, WS_LST); bf16* Gb = WSP(A, bf16, WS_G);
    const float* cw = A->in[I_CONVW]; const float* cb = A->in[I_CONVB];
    for (int task = blockIdx.x * (NWAVES * 64) + tid; task < (MS / 128) * 2 * (DFF / 8); task += NT) {
        const int ck = task % (DFF / 8), rs = task / (DFF / 8), seg = rs >> 1, bot = rs & 1, f0 = ck * 8;
        const int gc = 256 * (f0 >> 7) + (f0 & 127);
        const int row = seg * 128 + (bot ? 127 : 0);
        const bf16* e0 = EDGE + (size_t)(seg * 4) * NUP + gc;
        const bf16 *pp, *pc, *pn; bool hp = true, hn = true;
        if (!bot) { pc = e0; pn = e0 + NUP; pp = e0 - NUP; hp = (row & (SEQ - 1)) != 0; }
        else { pp = e0 + 2 * NUP; pc = e0 + 3 * NUP; pn = e0 + 4 * NUP; hn = ((row + 1) & (SEQ - 1)) != 0; }
        unsigned ow[4];
        const v4u z4 = (v4u){0u, 0u, 0u, 0u};
        const v4u apv = hp ? *(const GAS v4u*)pp : z4, acv = *(const GAS v4u*)pc, anv = hn ? *(const GAS v4u*)pn : z4;
        const v4u lpv = hp ? *(const GAS v4u*)(pp + 128) : z4, lcv = *(const GAS v4u*)(pc + 128), lnv = hn ? *(const GAS v4u*)(pn + 128) : z4;
#define UNPK4(v, h) ((f32x4){bflo((v)[2 * (h)]), bfhi((v)[2 * (h)]), bflo((v)[2 * (h) + 1]), bfhi((v)[2 * (h) + 1])})
#pragma unroll
        for (int h4 = 0; h4 < 2; ++h4) {
            const f32x4 ap = UNPK4(apv, h4), ac = UNPK4(acv, h4), an = UNPK4(anv, h4);
            const f32x4 lp = UNPK4(lpv, h4), lcur = UNPK4(lcv, h4), ln = UNPK4(lnv, h4);
            const int oa = f0 + 4 * h4, ol = DFF + f0 + 4 * h4;
            const f32x4 a = ap * *(const GAS f32x4*)(cw + oa) + ac * *(const GAS f32x4*)(cw + NUP + oa) + an * *(const GAS f32x4*)(cw + 2 * NUP + oa) + *(const GAS f32x4*)(cb + oa);
            const f32x4 l = lp * *(const GAS f32x4*)(cw + ol) + lcur * *(const GAS f32x4*)(cw + NUP + ol) + ln * *(const GAS f32x4*)(cw + 2 * NUP + ol) + *(const GAS f32x4*)(cb + ol);
            ow[2 * h4] = pk2(gelu_tanh(a[0]) * l[0], gelu_tanh(a[1]) * l[1]); ow[2 * h4 + 1] = pk2(gelu_tanh(a[2]) * l[2], gelu_tanh(a[3]) * l[3]); }
        *(GAS v4u*)(Gb + (size_t)row * DFF + f0) = (v4u){ow[0], ow[1], ow[2], ow[3]};
#undef UNPK4
    }
}
__device__ __forceinline__ void conv_fixup_tile(Frame& F_, int pm) {
    const KArgs A = get_args();
    const int tid = launder_v(F_.tid);
    const bf16* EDGE = WSP(A, bf16, WS_LST); bf16* Gb = WSP(A, bf16, WS_G);
    const float* cw = A->in[I_CONVW]; const float* cb = A->in[I_CONVB];
    for (int task = tid; task < 4 * (DFF / 8); task += NWAVES * 64) {
        const int ck = task % (DFF / 8), rs = task / (DFF / 8), seg = 2 * pm + (rs >> 1), bot = rs & 1, f0 = ck * 8;
        const int gc = 256 * (f0 >> 7) + (f0 & 127);
        const int row = seg * 128 + (bot ? 127 : 0);
        const bf16* e0 = EDGE + (size_t)(seg * 4) * NUP + gc;
        const bf16 *pp, *pc, *pn; bool hp = true, hn = true;
        if (!bot) { pc = e0; pn = e0 + NUP; pp = e0 - NUP; hp = (row & (SEQ - 1)) != 0; }
        else { pp = e0 + 2 * NUP; pc = e0 + 3 * NUP; pn = e0 + 4 * NUP; hn = ((row + 1) & (SEQ - 1)) != 0; }
        unsigned ow[4];
        const v4u z4 = (v4u){0u, 0u, 0u, 0u};
        const v4u apv = hp ? *(const GAS v4u*)pp : z4, acv = *(const GAS v4u*)pc, anv = hn ? *(const GAS v4u*)pn : z4;
        const v4u lpv = hp ? *(const GAS v4u*)(pp + 128) : z4, lcv = *(const GAS v4u*)(pc + 128), lnv = hn ? *(const GAS v4u*)(pn + 128) : z4;
#define UNPK4(v, h) ((f32x4){bflo((v)[2 * (h)]), bfhi((v)[2 * (h)]), bflo((v)[2 * (h) + 1]), bfhi((v)[2 * (h) + 1])})
#pragma unroll
        for (int h4 = 0; h4 < 2; ++h4) {
            const f32x4 ap = UNPK4(apv, h4), ac = UNPK4(acv, h4), an = UNPK4(anv, h4);
            const f32x4 lp = UNPK4(lpv, h4), lcur = UNPK4(lcv, h4), ln = UNPK4(lnv, h4);
            const int oa = f0 + 4 * h4, ol = DFF + f0 + 4 * h4;
            const f32x4 a = ap * *(const GAS f32x4*)(cw + oa) + ac * *(const GAS f32x4*)(cw + NUP + oa) + an * *(const GAS f32x4*)(cw + 2 * NUP + oa) + *(const GAS f32x4*)(cb + oa);
            const f32x4 l = lp * *(const GAS f32x4*)(cw + ol) + lcur * *(const GAS f32x4*)(cw + NUP + ol) + ln * *(const GAS f32x4*)(cw + 2 * NUP + ol) + *(const GAS f32x4*)(cb + ol);
            ow[2 * h4] = pk2(gelu_tanh(a[0]) * l[0], gelu_tanh(a[1]) * l[1]); ow[2 * h4 + 1] = pk2(gelu_tanh(a[2]) * l[2], gelu_tanh(a[3]) * l[3]); }
        *(GAS v4u*)(Gb + (size_t)row * DFF + f0) = (v4u){ow[0], ow[1], ow[2], ow[3]};
#undef UNPK4
    }
}
#ifndef REP_P0
#define REP_P0 1
#endif
#ifndef REP_P1
#define REP_P1 1
#endif
#ifndef REP_P2
#define REP_P2 1
#endif
#ifndef REP_P3
#define REP_P3 1
#endif
#ifndef REP_P4
#define REP_P4 1
#endif
#ifndef REP_P5
#define REP_P5 1
#endif
#ifndef REP_P6
#define REP_P6 1
#endif
#ifndef REP_P7
#define REP_P7 1
#endif
#ifndef REP_P8
#define REP_P8 1
#endif
#ifndef REP_P9
#define REP_P9 1
#endif
#ifndef REP_P10
#define REP_P10 1
#endif
#ifndef REP_P11
#define REP_P11 1
#endif
#ifndef EN_P0
#define EN_P0 1
#endif
#ifndef EN_P1
#define EN_P1 1
#endif
#ifndef EN_P2
#define EN_P2 1
#endif
#ifndef EN_P3
#define EN_P3 1
#endif
#ifndef EN_P4
#define EN_P4 1
#endif
#ifndef EN_P5
#define EN_P5 1
#endif
#ifndef EN_P6
#define EN_P6 1
#endif
#ifndef EN_P7
#define EN_P7 1
#endif
#ifndef EN_P8
#define EN_P8 1
#endif
#ifndef EN_P9
#define EN_P9 1
#endif
#ifndef EN_P10
#define EN_P10 1
#endif
#ifndef EN_P11
#define EN_P11 1
#endif
#ifndef PROBE_ALT
#define PROBE_ALT 0
#endif
#ifndef PROBE_DRY8
#define PROBE_DRY8 0
#endif
#ifndef FOLD_FIXUP
#define FOLD_FIXUP 0
#endif
#ifndef PROBE_NT8
#define PROBE_NT8 0
#endif
#ifndef PROBE_ZERO
#define PROBE_ZERO 0
#endif
#ifndef PROBE_BAR2
#define PROBE_BAR2 0
#endif
#ifndef FUSE_CONV
#define FUSE_CONV 1
#endif
#ifndef PROBE_DRY
#define PROBE_DRY 0
#endif
#ifndef STG_P2
#define STG_P2 0
#endif
#ifndef STG_P6
#define STG_P6 0
#endif
#ifndef STG_P8
#define STG_P8 0
#endif
#ifndef STG_P10
#define STG_P10 0
#endif
__device__ __forceinline__ void stagger(int window_ticks) {
    if (window_ticks <= 0) return;
    const unsigned x = (unsigned)__builtin_amdgcn_s_getreg((3 << 11) | 20) & 7u;
    const unsigned long long wait = ((unsigned long long)x * (unsigned)window_ticks) >> 3, t0 = __builtin_amdgcn_s_memrealtime();
    while (__builtin_amdgcn_s_memrealtime() - t0 < wait) __builtin_amdgcn_s_sleep(16);
}
__device__ __forceinline__ void stagger_blk(int window_ticks) {
    if (window_ticks <= 0) return;
    const unsigned b = __builtin_bitreverse32((unsigned)blockIdx.x) >> 24;
    const unsigned long long wait = ((unsigned long long)b * (unsigned)window_ticks) >> 8, t0 = __builtin_amdgcn_s_memrealtime();
    while (__builtin_amdgcn_s_memrealtime() - t0 < wait) __builtin_amdgcn_s_sleep(16);
}
#ifndef PROBE_C3
#define PROBE_C3 0
#endif
#ifndef STG_P5
#define STG_P5 0
#endif
#ifndef STG_P3
#define STG_P3 0
#endif
__global__ void __launch_bounds__(NWAVES * 64, 2) enc_fwd(Args args) {
    extern __shared__ __attribute__((aligned(16))) unsigned char lds[];
    Frame F;
    F.lds = (LAS unsigned char*)lds;
    F.MISC = (volatile LAS unsigned*)(F.lds + MISC_OFF);
    F.tid = threadIdx.x; F.lane = F.tid & 63; F.wave = __builtin_amdgcn_readfirstlane(F.tid >> 6);
    F.G = gridDim.x; { const int bx = blockIdx.x; F.vcu = (F.G % 8 == 0) ? (bx % 8) * (F.G / 8) + bx / 8 : bx; }
    for (int u = F.tid; u < (LDS_BYTES - LDSCTL_OFF) / 4; u += NWAVES * 64) ((LAS unsigned*)(F.lds + LDSCTL_OFF))[u] = 0u;
    __syncthreads();
    XcdBarrier bar; bar.bar = (unsigned*)(args.ws + WS_CTL) + CW_BAR; bar.x = 0; bar.st = nullptr;
    if (!MK_PER_PHASE) bar = xcd_barrier_post((unsigned*)(args.ws + WS_CTL) + CW_BAR, F.MISC + 8);
#define GRID_BAR() do { if (MK_PER_PHASE) { if (F.tid == 0) __hip_atomic_store((gu32*)bar.bar - CW_BAR + CW_TMO, 0xBADBA0u, RLX_AGENT); } else { xcd_barrier(bar); if (PROBE_BAR2) xcd_barrier(bar); } } while (0)
    const int lo = args.ph_lo, hi = args.ph_hi;
#define IN(k) (lo <= (k) && (k) < hi)
#define BOTH(k) (IN(k) && IN((k) + 1))
#define XS(A, s) ((s) < 2 ? (A)->in[I_XP] + (size_t)(s) * MS * D : (A)->in[I_XS])
#define OUTS(A, s) ((A)->out + (size_t)(s) * MS * D)

    if (EN_P0 && IN(0)) { p0_prologue(F); if (BOTH(0)) GRID_BAR(); }

    for (int s = 0; s < NSLAB; ++s) {
        const int pb = 1 + s * PH_PER_SLAB;
        const int b0 = s * SLAB_SEQ;
        if (EN_P1 && IN(pb + 0) && (s == 0 || MK_PER_PHASE)) { for (int rep_ = 0, nrep_ = launder_s(REP_P1); rep_ < nrep_; ++rep_) { const KArgs A = get_args();
            norm_rows_bf16<0>(F, XS(A, s), (bf16*)nullptr, A->in[I_GMIX], WSP(A, float, WS_MOD) + 1 * D, WSP(A, float, WS_MOD) + 0 * D, b0, WSP(A, bf16, WS_H)); } if (BOTH(pb + 0)) GRID_BAR(); }
        if (EN_P2 && IN(pb + 1)) { for (int rep_ = 0, nrep_ = launder_s(REP_P2); rep_ < nrep_; ++rep_) { const KArgs A = get_args();
            pg8::Gemm g{WSP(A, bf16, WS_H), WSP(A, bf16, WS_WIN), MS, NIN, D}; pg8::StaticOrder S; S.init(MS, NIN, F.G, (int)blockIdx.x); S.zero = (rep_ > 0 ? PROBE_ZERO : 0);
            pg8::EpiProj E{(rep_ > 0 && (PROBE_ZERO || PROBE_ALT)) ? WSP(A, bf16, WS_G) : WSP(A, bf16, WS_PROJ), NPJ, WSP(A, float, WS_COS), WSP(A, float, WS_SIN), (rep_ > 0 ? PROBE_DRY : 0)};
            pg8::gemm_phase<pg8::EpiProj, pg8::StaticOrder, PG8_ALIGN, PG8_SP2>(F.lds + RING_OFF, g, S, E);
            } if (BOTH(pb + 1)) GRID_BAR();
        }
        if (EN_P3 && IN(pb + 2)) { for (int rep_ = 0, nrep_ = launder_s(REP_P3); rep_ < nrep_; ++rep_) { stagger_blk(STG_P3); c1_phase(F); __syncthreads(); pool_units(F); } if (BOTH(pb + 2)) GRID_BAR(); }
        if (EN_P4 && IN(pb + 3)) { for (int rep_ = 0, nrep_ = launder_s(REP_P4); rep_ < nrep_; ++rep_) { c2_scan(F); } if (BOTH(pb + 3)) GRID_BAR(); }
        if (EN_P5 && IN(pb + 4)) { for (int rep_ = 0, nrep_ = launder_s(REP_P5); rep_ < nrep_; ++rep_) { stagger_blk(STG_P5); c3_phase(F, rep_ > 0 ? PROBE_C3 : 0); } if (BOTH(pb + 4)) GRID_BAR(); }
        if (EN_P6 && IN(pb + 5)) { for (int rep_ = 0, nrep_ = launder_s(REP_P6); rep_ < nrep_; ++rep_) { const KArgs A = get_args();
            pg8::Gemm g{WSP(A, bf16, WS_MERGED), WSP(A, bf16, WS_WOUT), MS, D, D}; pg8::StaticOrder S; S.init(MS, D, F.G, (int)blockIdx.x);
            pg8::EpiGateBf16 E{WSP(A, bf16, WS_BB), WSP(A, float, WS_MOD) + 2 * D, b0};
            pg8::gemm_phase<pg8::EpiGateBf16, pg8::StaticOrder, PG8_ALIGN, PG8_SP2>(F.lds + RING_OFF, g, S, E);
            } if (BOTH(pb + 5)) GRID_BAR();
        }
        if (EN_P7 && IN(pb + 6)) { for (int rep_ = 0, nrep_ = launder_s(REP_P7); rep_ < nrep_; ++rep_) { const KArgs A = get_args();
            norm_rows_bf16<1>(F, XS(A, s), WSP(A, bf16, WS_BB), A->in[I_GFFN], WSP(A, float, WS_MOD) + 4 * D, WSP(A, float, WS_MOD) + 3 * D, b0, WSP(A, bf16, WS_H)); } if (BOTH(pb + 6)) GRID_BAR(); }
        if (EN_P8 && IN(pb + 7)) { for (int rep_ = 0, nrep_ = launder_s(REP_P8); rep_ < nrep_; ++rep_) { const KArgs A = get_args();
            pg8::Gemm g{WSP(A, bf16, WS_H), WSP(A, bf16, WS_WUP), MS, NUP, D, (rep_ > 0 ? PROBE_NT8 : 0)}; pg8::StaticOrder S; S.init(MS, NUP, F.G, (int)blockIdx.x);
#if FUSE_CONV
            pg8::EpiConv E{WSP(A, bf16, WS_G), WSP(A, float, WS_LST), A->in[I_CONVW], A->in[I_CONVB], (rep_ > 0 ? PROBE_DRY8 : 0)};
            pg8::gemm_phase<pg8::EpiConv, pg8::StaticOrder, PG8_ALIGN, PG8_SP2>(F.lds + RING_OFF, g, S, E);
#else
            pg8::EpiStoreBf16 E{WSP(A, bf16, WS_PROJ), NUP};
            pg8::gemm_phase<pg8::EpiStoreBf16, pg8::StaticOrder, PG8_ALIGN, PG8_SP2>(F.lds + RING_OFF, g, S, E);
#endif
            } if (BOTH(pb + 7)) GRID_BAR();
        }
        if (EN_P9 && IN(pb + 8) && !(FUSE_CONV && FOLD_FIXUP && !MK_PER_PHASE)) { for (int rep_ = 0, nrep_ = launder_s(REP_P9); rep_ < nrep_; ++rep_) { if (FUSE_CONV) conv_fixup_phase(F); else conv_gelu_phase(F); } if (BOTH(pb + 8)) GRID_BAR(); }
        if (EN_P10 && IN(pb + 9)) { for (int rep_ = 0, nrep_ = launder_s(REP_P10); rep_ < nrep_; ++rep_) { const KArgs A = get_args();
            pg8::Gemm g{WSP(A, bf16, WS_G), WSP(A, bf16, WS_WDOWN), MS, D, DFF}; pg8::StaticOrder S; S.init(MS, D, F.G, (int)blockIdx.x);
            if (FUSE_CONV && FOLD_FIXUP && !MK_PER_PHASE) { pg8::Unit fu; for (int i = 0; S.next(i, fu); ++i) conv_fixup_tile(F, fu.pm); VM_WAIT(); __syncthreads(); }
            pg8::EpiGateBf16 E{WSP(A, bf16, WS_MERGED), WSP(A, float, WS_MOD) + 5 * D, b0};
            pg8::gemm_phase<pg8::EpiGateBf16, pg8::StaticOrder, PG8_ALIGN, PG8_SP2>(F.lds + RING_OFF, g, S, E);
            } if (BOTH(pb + 9)) GRID_BAR();
        }
        if (EN_P11 && IN(pb + 10)) { for (int rep_ = 0, nrep_ = launder_s(REP_P11); rep_ < nrep_; ++rep_) { const KArgs A = get_args(); final_norm_rows(F, WSP(A, bf16, WS_BB), WSP(A, bf16, WS_MERGED), OUTS(A, s), A->in[I_GFINAL]);
            if (!MK_PER_PHASE && s + 1 < NSLAB) norm_rows_bf16<0>(F, XS(A, s + 1), (bf16*)nullptr, A->in[I_GMIX], WSP(A, float, WS_MOD) + 1 * D, WSP(A, float, WS_MOD) + 0 * D, b0 + SLAB_SEQ, WSP(A, bf16, WS_H)); } if (BOTH(pb + 10)) GRID_BAR(); }
    }
#undef IN
#undef BOTH
}

extern "C" void kernel_launch(void* const* d_in, const int* in_sizes, int n_in, void* d_out, int out_size, void* d_ws, size_t ws_size, hipStream_t stream) {
    static int grid = 0;
    if (grid == 0) {
        if (n_in != 20 || out_size != NSEQ * SEQ * D || ws_size < WS_END) { fprintf(stderr, "kernel_launch: unexpected shapes (n_in %d, out %d, ws %zu); nothing launched\n", n_in, out_size, ws_size); grid = -1; return; }
        int dev = 0, cus = 0, per_cu = 0;
        if (hipGetDevice(&dev) != hipSuccess || hipDeviceGetAttribute(&cus, hipDeviceAttributeMultiprocessorCount, dev) != hipSuccess) { grid = -1; return; }
        if (hipFuncSetAttribute((const void*)enc_fwd, hipFuncAttributeMaxDynamicSharedMemorySize, LDS_BYTES) != hipSuccess) { fprintf(stderr, "kernel_launch: hipFuncSetAttribute failed\n"); grid = -1; return; }
        if (hipOccupancyMaxActiveBlocksPerMultiprocessor(&per_cu, (const void*)enc_fwd, NWAVES * 64, LDS_BYTES) != hipSuccess || per_cu < 1) fprintf(stderr, "kernel_launch: occupancy query reports %d\n", per_cu);
        (void)hipGetLastError();
        grid = cus;
    }
    if (grid < 0) return;
    if (hipMemsetAsync((char*)d_ws + WS_CTL, 0, CTL_ZERO_BYTES, stream) != hipSuccess) return;
    Args a{};
    for (int i = 0; i < 20; ++i) a.in[i] = (const float*)d_in[i];
    a.out = (float*)d_out; a.ws = (unsigned char*)d_ws;
#if MK_PER_PHASE
    for (int p = 0; p < NPHASE; ++p) { a.ph_lo = p; a.ph_hi = p + 1; hipLaunchKernelGGL(enc_fwd, dim3(grid), dim3(NWAVES * 64), LDS_BYTES, stream, a); }
#else
    a.ph_lo = 0; a.ph_hi = NPHASE;
    hipLaunchKernelGGL(enc_fwd, dim3(grid), dim3(NWAVES * 64), LDS_BYTES, stream, a);
#endif
}
```

```cpp
#include <hip/hip_runtime.h>
#include <cstdio>
#include <cstdint>
#define NT_KVP 1
#ifndef PG8_ROTPN
#define PG8_ROTPN 3
#endif
#ifndef PG8_WGM
#define PG8_WGM 8
#endif
namespace pg8 {
#define PG8_LAS __attribute__((address_space(3)))
typedef unsigned short bf16_t;
typedef short bf16x8 __attribute__((ext_vector_type(8)));
typedef float f32x4 __attribute__((ext_vector_type(4)));
typedef unsigned u32x4 __attribute__((ext_vector_type(4)));
constexpr int BM = 256, BK = 64, HALF = 128, HTB = HALF * BK * 2  , STAGE_BYTES = 8 * HTB, NXCD = 8, WGM = PG8_WGM;

__host__ __device__ __forceinline__ int lds_byte(int r, int c) { const int st = (r >> 4) * 2 + (c >> 5), rr = r & 15, cc = c & 31, ob = rr * 64 + cc * 2; return st * 1024 + (ob ^ (((ob >> 9) & 1) << 5)); }
__host__ __device__ __forceinline__ void stage_rc(int b, int& R, int& C) { const int st = b / 1024, sb = b % 1024, swz = sb ^ (((sb >> 9) & 1) << 5); R = (st >> 1) * 16 + swz / 64; C = (st & 1) * 32 + (swz % 64) / 2; }
__host__ __device__ __forceinline__ int perm32(int rho) { const int n = rho >> 4, i = rho & 15; return 8 * (i >> 2) + 4 * n + (i & 3); }

struct Unit { int pm, pn; };
struct Gemm { const bf16_t* A; const bf16_t* Bt; int M, N, K; int ntx = 0; };

struct StaticOrder {
    int nM, nN, nwg, G, c; int zero = 0; int rot = 0;
    __host__ __device__ void init(int M, int N, int G_, int c_) { nM = M / BM; nN = N / BM; nwg = nM * nN; G = G_; c = c_; }
    __host__ __device__ bool next(int i, Unit& u) const {
        const long L = (long)i * G + c; if (L >= nwg) return false;
        int wgid = (int)L; { const int q = nwg / NXCD, r = nwg % NXCD, xcd = wgid % NXCD, off = wgid / NXCD; wgid = (xcd < r ? xcd * (q + 1) : r * (q + 1) + (xcd - r) * q) + off; }
        const int nig = WGM * nN, gid = wgid / nig, fm = gid * WGM, gsz = (nM - fm) < WGM ? (nM - fm) : WGM;
        u.pm = fm + ((wgid % nig) % gsz); u.pn = (wgid % nig) / gsz;
        if (rot && (nwg / NXCD) % nig == 0 && nwg % NXCD == 0) u.pn = (u.pn + rot * (int)(L % NXCD)) % nN;
        if (zero) { u.pm = 0; u.pn = 4; } return true;
    }
    __device__ __forceinline__ void a_ready(const Unit&) const {}
    __device__ __forceinline__ void done(const Unit&) const {}
};
typedef float f32x2c_ __attribute__((ext_vector_type(2))); typedef __bf16 bf16x2c_ __attribute__((ext_vector_type(2)));
__device__ __forceinline__ unsigned cvt_pk_bf16(float lo, float hi) { const bf16x2c_ r = __builtin_convertvector((f32x2c_){lo, hi}, bf16x2c_); return __builtin_bit_cast(unsigned, r); }
typedef float f32x2 __attribute__((ext_vector_type(2)));
#ifndef NT_GATE
#define NT_GATE 0
#endif
#ifndef RELAX_EPI
#define RELAX_EPI 1
#endif
#ifndef RES_GROUP
#define RES_GROUP 1
#endif
#ifndef PROBE_EPIVALU
#define PROBE_EPIVALU 0
#endif
#ifndef PROBE_CONTIG
#define PROBE_CONTIG 0
#endif
#ifndef ROT_FLY
#define ROT_FLY 1
#endif
#ifndef EPI_ZERO
#define EPI_ZERO 1
#endif
#ifndef NT_KVP
#define NT_KVP 0
#endif
#ifndef NT_STORE
#define NT_STORE 1
#endif
typedef float f32x2p __attribute__((ext_vector_type(2)));
__device__ __forceinline__ f32x2p gateA2(f32x2p gs, f32x2p ga) {
    const f32x2p xs = gs * -1.4426950408889634f, xa = ga * -1.4426950408889634f;
    f32x2p es, ea; es.x = __builtin_amdgcn_exp2f(xs.x); es.y = __builtin_amdgcn_exp2f(xs.y); ea.x = __builtin_amdgcn_exp2f(xa.x); ea.y = __builtin_amdgcn_exp2f(xa.y);
    const f32x2p d = (es + 1.0f) * (ea + 1.0f);
    f32x2p r; r.x = __builtin_amdgcn_rcpf(d.x); r.y = __builtin_amdgcn_rcpf(d.y);
    return gs * r;
}
__device__ __forceinline__ f32x2p gateB2(f32x2p gb) {
    const f32x2p x = gb * -1.4426950408889634f;
    f32x2p e; e.x = __builtin_amdgcn_exp2f(x.x); e.y = __builtin_amdgcn_exp2f(x.y); e = e + 1.0f;
    f32x2p r; r.x = __builtin_amdgcn_rcpf(e.x); r.y = __builtin_amdgcn_rcpf(e.y);
    return r;
}
#ifndef PJ_TILE_MASK
#define PJ_TILE_MASK 15
#endif
__host__ __device__ __forceinline__ constexpr bool pj_tiled(int colbase) { return (PJ_TILE_MASK & (colbase < 1024 ? 1 : (colbase < 2048 ? 2 : (colbase == 3072 ? 8 : 4)))) != 0; }
__host__ __device__ __forceinline__ constexpr int pj_pitch(int colbase, int H, int w) { return pj_tiled(colbase) ? w : H * w; }
__host__ __device__ __forceinline__ size_t pj_blk(int colbase, int H, int w, int chunk, int head) {
    return (size_t)32768 * colbase + (size_t)chunk * (size_t)(128 * H * w) + (size_t)(pj_tiled(colbase) ? head * 128 * w : head * w); }
struct EpiProj {
    static __device__ __forceinline__ int nops(const Unit& u) { return (u.pn >= 8 && u.pn < 16) ? 8 : 16; }
    static constexpr bool PERM = true, AFTER_DRAIN = false, HAS_PRE = false, ROWPERM = false, HAS_PF = false, ZEROS_ACC = (EPI_ZERO != 0); static constexpr int NST = 16;
    bf16_t* O; int ldc; const float* cosT; const float* sinT; int dry;
    template <int KIND>
    __device__ __forceinline__ void body(f32x4 (&acc)[2][2][4][2], int row0, size_t base0, int aistep, int wcol, int bjstep, int fi0, float sc) const {
        float invf[4];
        if constexpr (KIND == 1 && ROT_FLY) {
            const bool hi = fi0 >= 16; const int q4 = (fi0 >> 2) & 3;
#define ROT_SEL(a, b, c, d, e_, f_, g_, h_) (hi ? (q4 == 0 ? (e_) : q4 == 1 ? (f_) : q4 == 2 ? (g_) : (h_)) : (q4 == 0 ? (a) : q4 == 1 ? (b) : q4 == 2 ? (c) : (d)))
            invf[0] = ROT_SEL(1.000000000e+00f, 3.162277639e-01f, 1.000000015e-01f, 3.162277490e-02f, 9.999999776e-03f, 3.162277630e-03f, 1.000000047e-03f, 3.162277571e-04f);
            invf[1] = ROT_SEL(7.498942018e-01f, 2.371373773e-01f, 7.498942316e-02f, 2.371373773e-02f, 7.498942316e-03f, 2.371373819e-03f, 7.498941850e-04f, 2.371373703e-04f);
            invf[2] = ROT_SEL(5.623413324e-01f, 1.778279394e-01f, 5.623413250e-02f, 1.778279431e-02f, 5.623413250e-03f, 1.778279431e-03f, 5.623413017e-04f, 1.778279402e-04f);
            invf[3] = ROT_SEL(4.216965139e-01f, 1.333521456e-01f, 4.216964915e-02f, 1.333521400e-02f, 4.216964822e-03f, 1.333521446e-03f, 4.216965172e-04f, 1.333521504e-04f);
#undef ROT_SEL
        }
#pragma unroll
        for (int ai = 0; ai < 2; ++ai)
#pragma unroll
            for (int m = 0; m < 4; ++m) { const int row = row0 + ai * HALF + m * 16; bf16_t* rowp = O + base0 + (size_t)(ai * aistep + m * 16 * wcol);
                if constexpr (KIND == 2) {
                    f32x4 a0, a1; const f32x4 gs0 = acc[ai][0][m][0], gs1 = acc[ai][0][m][1], ga0 = acc[ai][1][m][0], ga1 = acc[ai][1][m][1];
#pragma unroll
                    for (int hp = 0; hp < 2; ++hp) {
                        const f32x2p r0 = gateA2((f32x2p){gs0[2 * hp], gs0[2 * hp + 1]}, (f32x2p){ga0[2 * hp], ga0[2 * hp + 1]}), r1 = gateA2((f32x2p){gs1[2 * hp], gs1[2 * hp + 1]}, (f32x2p){ga1[2 * hp], ga1[2 * hp + 1]});
                        a0[2 * hp] = r0.x; a0[2 * hp + 1] = r0.y; a1[2 * hp] = r1.x; a1[2 * hp + 1] = r1.y; }
                    u32x4 w; w.x = cvt_pk_bf16(a0[0], a0[1]); w.y = cvt_pk_bf16(a0[2], a0[3]); w.z = cvt_pk_bf16(a1[0], a1[1]); w.w = cvt_pk_bf16(a1[2], a1[3]);
                    if (!dry) { if (NT_STORE) __builtin_nontemporal_store(w, (u32x4*)rowp); else *(u32x4*)rowp = w; }
                } else {
                    f32x4 c4, s4;
                    if constexpr (KIND == 1 && !ROT_FLY) { const int pos = row & 8191; c4 = *(const f32x4*)(cosT + pos * 32 + fi0); s4 = *(const f32x4*)(sinT + pos * 32 + fi0); }
                    if constexpr (KIND == 1 && ROT_FLY) {
                        const float posf = (float)(row & 8191);
#pragma unroll
                        for (int e = 0; e < 4; ++e) { const float ang = posf * invf[e];
                            const float pr = ang * 1.591549367e-01f, er = __builtin_fmaf(ang, 1.591549367e-01f, -pr), fr_ = pr - __builtin_rintf(pr), r = fr_ + __builtin_fmaf(ang, 6.420638243e-09f, er);
                            c4[e] = __builtin_amdgcn_cosf(r); s4[e] = __builtin_amdgcn_sinf(r); } }
#pragma unroll
                    for (int bj = 0; bj < 2; ++bj) { f32x4 v0 = acc[ai][bj][m][0], v1 = acc[ai][bj][m][1];
                        if constexpr (KIND == 1) { const f32x4 o0 = v0 * c4 - v1 * s4, o1 = v0 * s4 + v1 * c4; v0 = o0 * sc; v1 = o1 * sc; }
                        if constexpr (KIND == 3) {
#pragma unroll
                            for (int hp = 0; hp < 2; ++hp) { const f32x2p r0 = gateB2((f32x2p){v0[2 * hp], v0[2 * hp + 1]}), r1 = gateB2((f32x2p){v1[2 * hp], v1[2 * hp + 1]});
                                v0[2 * hp] = r0.x; v0[2 * hp + 1] = r0.y; v1[2 * hp] = r1.x; v1[2 * hp + 1] = r1.y; } }
                        u32x4 w; w.x = cvt_pk_bf16(v0[0], v0[1]); w.y = cvt_pk_bf16(v0[2], v0[3]); w.z = cvt_pk_bf16(v1[0], v1[1]); w.w = cvt_pk_bf16(v1[2], v1[3]);
                        if (!dry) { if (NT_STORE && !(NT_KVP && KIND == 0)) __builtin_nontemporal_store(w, (u32x4*)(rowp + bj * bjstep)); else *(u32x4*)(rowp + bj * bjstep) = w; } }
                }
                if (EPI_ZERO) {
#pragma unroll
                    for (int bj = 0; bj < 2; ++bj)
#pragma unroll
                        for (int n = 0; n < 2; ++n) acc[ai][bj][m][n] = (f32x4){0.f, 0.f, 0.f, 0.f}; } }
    }
    __device__ __forceinline__ void operator()(f32x4 (&acc)[2][2][4][2], const Unit& u, int wr, int wc, int fr, int fq) const {
        const int row0 = u.pm * BM + wr * 64 + fr, lc = wc * 32 + 8 * fq;
        const int pn = u.pn;
        const bool rot = pn < 4, isA = pn >= 8 && pn < 16, isB = pn >= 18; const float sc = (pn >= 2 && pn < 4) ? 0.125f : 1.0f;
        const int colbase = pn < 2 ? 0 : (pn < 4 ? 512 : (pn < 8 ? 1024 : (pn < 16 ? 2048 : (pn < 18 ? 3072 : 3584))));
        const int H = (pn >= 16 && pn < 18) ? 4 : 8, wcol = pn < 4 ? 64 : 128;
        const int head0 = pn < 4 ? 4 * (pn & 1) + (lc >> 6) : (pn < 8 ? 2 * (pn - 4) : (pn < 16 ? pn - 8 : (pn < 18 ? 2 * (pn - 16) : 2 * (pn - 18))));
        const int jcol = pn < 4 ? (lc & 63) : lc, hstep = pn < 4 ? 2 : 1;
        const bool tl = pj_tiled(colbase); const int pitch = tl ? wcol : H * wcol;
        const size_t base0 = pj_blk(colbase, H, wcol, 2 * u.pm, head0) + (size_t)((wr * 64 + fr) * pitch + jcol);
        const int aistep = H * 128 * wcol, bjstep = tl ? hstep * 128 * wcol : hstep * wcol;
        const int fi0 = ((wc & 1) * 32 + 8 * fq) >> 1;
        if (isA) body<2>(acc, row0, base0, aistep, pitch, bjstep, fi0, sc); else if (isB) body<3>(acc, row0, base0, aistep, pitch, bjstep, fi0, sc); else if (rot) body<1>(acc, row0, base0, aistep, pitch, bjstep, fi0, sc); else body<0>(acc, row0, base0, aistep, pitch, bjstep, fi0, sc);
    }
};
struct EpiStoreBf16 {
    static __device__ __forceinline__ int nops(const Unit&) { return 16; }
    static constexpr bool PERM = true, AFTER_DRAIN = false, HAS_PRE = false, ROWPERM = false, HAS_PF = false, ZEROS_ACC = false; static constexpr int NST = 16;
    bf16_t* O; int ldc;
    __device__ __forceinline__ void operator()(const f32x4 (&acc)[2][2][4][2], const Unit& u, int wr, int wc, int fr, int fq) const {
        const int row0 = u.pm * BM + wr * 64 + fr, col0 = u.pn * BM + wc * 32 + 8 * fq;
#pragma unroll
        for (int ai = 0; ai < 2; ++ai)
#pragma unroll
            for (int m = 0; m < 4; ++m) { bf16_t* rowp = O + (size_t)(row0 + ai * HALF + m * 16) * ldc + col0;
#pragma unroll
                for (int bj = 0; bj < 2; ++bj) { const f32x4 v0 = acc[ai][bj][m][0], v1 = acc[ai][bj][m][1];
                    u32x4 w; w.x = cvt_pk_bf16(v0[0], v0[1]); w.y = cvt_pk_bf16(v0[2], v0[3]); w.z = cvt_pk_bf16(v1[0], v1[1]); w.w = cvt_pk_bf16(v1[2], v1[3]);
                    if (NT_STORE) __builtin_nontemporal_store(w, (u32x4*)(rowp + bj * HALF)); else *(u32x4*)(rowp + bj * HALF) = w; } }
    }
};
template <int CTRL, bool BC> __device__ __forceinline__ float dppf(float old, float src) { return __builtin_bit_cast(float, __builtin_amdgcn_update_dpp(__builtin_bit_cast(int, old), __builtin_bit_cast(int, src), CTRL, 0xf, 0xf, BC)); }
__device__ __forceinline__ float row_above(float above_slot, float cur) { const float t = dppf<0x121, true>(0.f, above_slot); return dppf<0x111, false>(t, cur); }
__device__ __forceinline__ float row_below(float below_slot, float cur) { const float t = dppf<0x12F, true>(0.f, below_slot); return dppf<0x101, false>(t, cur); }
__device__ __forceinline__ float gelu_tanh_e(float x) { const float t = x * (-2.302208198f + -0.10294324f * x * x); return x * __builtin_amdgcn_rcpf(1.0f + __builtin_amdgcn_exp2f(t)); }
__device__ __forceinline__ float mul_ror1(float src, float w) { float d; asm("v_mul_f32_dpp %0, %1, %2 row_ror:1 row_mask:0xf bank_mask:0xf bound_ctrl:1" : "=v"(d) : "v"(src), "v"(w)); return d; }
__device__ __forceinline__ float mul_ror15(float src, float w) { float d; asm("v_mul_f32_dpp %0, %1, %2 row_ror:15 row_mask:0xf bank_mask:0xf bound_ctrl:1" : "=v"(d) : "v"(src), "v"(w)); return d; }
typedef float f32x2g __attribute__((ext_vector_type(2)));
__device__ __forceinline__ f32x2g gelu_mul2(f32x2g a, f32x2g l) {
    const f32x2g t = a * a, u = a * (t * -0.10294324f + -2.302208198f);
    f32x2g d; d.x = __builtin_amdgcn_exp2f(u.x); d.y = __builtin_amdgcn_exp2f(u.y); d = d + 1.0f;
    f32x2g r; r.x = __builtin_amdgcn_rcpf(d.x); r.y = __builtin_amdgcn_rcpf(d.y);
    return (a * l) * r;
}
struct EpiConv {
    static __device__ __forceinline__ int nops(const Unit&) { return 16; }
    static constexpr bool PERM = true, AFTER_DRAIN = false, HAS_PRE = true, ROWPERM = true, HAS_PF = false, ZEROS_ACC = false; static constexpr int NST = 16;
    bf16_t* G; float* EDGE; const float* cw; const float* cb; int dry;
    __device__ __forceinline__ void pre(PG8_LAS unsigned char* lfree, const Unit& nu, int slot, int tid) const {
        if (tid < 256) { const int sg = tid >> 5, tap = sg >> 1, hf = sg & 1;
            const float* src = (tap < 3 ? cw + tap * 5632 : cb) + hf * 2816 + 128 * nu.pn + (tid & 31) * 4;
            __builtin_amdgcn_global_load_lds((const unsigned*)src, (PG8_LAS unsigned*)(lfree + slot * 4096 + (tid >> 6) * 1024), 16, 0, 0); }
    }
    __device__ __forceinline__ void run(const f32x4 (&acc)[2][2][4][2], const Unit& u, int wr, int wc, int fr, int fq, PG8_LAS unsigned char* wslot) const {
        if (dry & 4) return;
        const int lc = wc * 32 + 8 * fq, f0 = 128 * u.pn + lc, row0 = u.pm * BM + wr * 128 + 4 * fr;
        f32x4 w[2][2][4];
#pragma unroll
        for (int n = 0; n < 2; ++n)
#pragma unroll
            for (int bj = 0; bj < 2; ++bj)
#pragma unroll
                for (int t = 0; t < 4; ++t) w[n][bj][t] = *(const PG8_LAS f32x4*)(wslot + ((t * 2 + bj) * 128 + lc + 4 * n) * 4);
#pragma unroll
        for (int ai = 0; ai < 2; ++ai) {
#pragma unroll
            for (int m = 0; m < 4; ++m) {
                unsigned pk[2][2];
#pragma unroll
                for (int n = 0; n < 2; ++n) {
                    f32x4 cv[2];
#pragma unroll
                    for (int bj = 0; bj < 2; ++bj) {
                        f32x4 xa, xb;
                        if (m == 0) {
#pragma unroll
                            for (int e = 0; e < 4; ++e) xa[e] = ai == 0 ? dppf<0x111, true>(0.f, acc[0][bj][3][n][e]) : row_above(acc[0][bj][3][n][e], acc[1][bj][3][n][e]); }
                        else xa = acc[ai][bj][m - 1][n];
                        if (m == 3) {
#pragma unroll
                            for (int e = 0; e < 4; ++e) xb[e] = ai == 1 ? dppf<0x101, true>(0.f, acc[1][bj][0][n][e]) : row_below(acc[1][bj][0][n][e], acc[0][bj][0][n][e]); }
                        else xb = acc[ai][bj][m + 1][n];
                        cv[bj] = xb * w[n][bj][2] + (xa * w[n][bj][0] + (acc[ai][bj][m][n] * w[n][bj][1] + w[n][bj][3])); }
                    const f32x2g g01 = gelu_mul2((f32x2g){cv[0][0], cv[0][1]}, (f32x2g){cv[1][0], cv[1][1]}), g23 = gelu_mul2((f32x2g){cv[0][2], cv[0][3]}, (f32x2g){cv[1][2], cv[1][3]});
                    pk[n][0] = cvt_pk_bf16(g01.x, g01.y); pk[n][1] = cvt_pk_bf16(g23.x, g23.y); }
                if (!(dry & 1)) { u32x4 o; o.x = pk[0][0]; o.y = pk[0][1]; o.z = pk[1][0]; o.w = pk[1][1]; if (NT_STORE) __builtin_nontemporal_store(o, (u32x4*)(G + (size_t)(row0 + ai * 64 + m) * 2816 + f0)); else *(u32x4*)(G + (size_t)(row0 + ai * 64 + m) * 2816 + f0) = o; }
            }
        }
        bf16_t* eseg = (bf16_t*)EDGE + (size_t)((u.pm * 2 + wr) * 4) * 5632 + u.pn * 256 + lc;
        if (fr == 0 && !(dry & 2)) {
#pragma unroll
            for (int m = 0; m < 2; ++m)
#pragma unroll
                for (int bj = 0; bj < 2; ++bj) { const f32x4 v0 = acc[0][bj][m][0], v1 = acc[0][bj][m][1]; u32x4 o; o.x = cvt_pk_bf16(v0[0], v0[1]); o.y = cvt_pk_bf16(v0[2], v0[3]); o.z = cvt_pk_bf16(v1[0], v1[1]); o.w = cvt_pk_bf16(v1[2], v1[3]);
                    *(u32x4*)(eseg + (size_t)m * 5632 + bj * HALF) = o; } }
        if (fr == 15 && !(dry & 2)) {
#pragma unroll
            for (int m = 2; m < 4; ++m)
#pragma unroll
                for (int bj = 0; bj < 2; ++bj) { const f32x4 v0 = acc[1][bj][m][0], v1 = acc[1][bj][m][1]; u32x4 o; o.x = cvt_pk_bf16(v0[0], v0[1]); o.y = cvt_pk_bf16(v0[2], v0[3]); o.z = cvt_pk_bf16(v1[0], v1[1]); o.w = cvt_pk_bf16(v1[2], v1[3]);
                    *(u32x4*)(eseg + (size_t)m * 5632 + bj * HALF) = o; } }
    }
};
struct EpiGateBf16 {
    static __device__ __forceinline__ int nops(const Unit&) { return 16; }
    static constexpr bool PERM = true, AFTER_DRAIN = false, HAS_PRE = false, ROWPERM = false, HAS_PF = true, ZEROS_ACC = (EPI_ZERO != 0); static constexpr int NST = 16;
    bf16_t* O; const float* gate; int b0;
    f32x4 gv[2][2];
    __device__ __forceinline__ void prefetch(const Unit& u, int wc, int fq) {
        const float* gp = gate + (size_t)(b0 + ((u.pm * BM) >> 13)) * 6144 + u.pn * BM + wc * 32 + 8 * fq;
#pragma unroll
        for (int bj = 0; bj < 2; ++bj)
#pragma unroll
            for (int n = 0; n < 2; ++n) gv[bj][n] = *(const f32x4*)(gp + bj * HALF + n * 4);
    }
    __device__ __forceinline__ void operator()(f32x4 (&acc)[2][2][4][2], const Unit& u, int wr, int wc, int fr, int fq) const {
        const int row0 = u.pm * BM + wr * 64 + fr, col0 = u.pn * BM + wc * 32 + 8 * fq;
#pragma unroll
        for (int ai = 0; ai < 2; ++ai)
#pragma unroll
            for (int m = 0; m < 4; ++m) { bf16_t* rowp = O + (size_t)(row0 + ai * HALF + m * 16) * 1024 + col0;
#pragma unroll
                for (int bj = 0; bj < 2; ++bj) { const f32x4 v0 = acc[ai][bj][m][0] * gv[bj][0], v1 = acc[ai][bj][m][1] * gv[bj][1];
                    u32x4 w; w.x = cvt_pk_bf16(v0[0], v0[1]); w.y = cvt_pk_bf16(v0[2], v0[3]); w.z = cvt_pk_bf16(v1[0], v1[1]); w.w = cvt_pk_bf16(v1[2], v1[3]);
                    if (NT_GATE) __builtin_nontemporal_store(w, (u32x4*)(rowp + bj * HALF)); else *(u32x4*)(rowp + bj * HALF) = w;
                    if (EPI_ZERO) { acc[ai][bj][m][0] = (f32x4){0.f, 0.f, 0.f, 0.f}; acc[ai][bj][m][1] = (f32x4){0.f, 0.f, 0.f, 0.f}; } } }
    }
};
struct EpiRes {
    static __device__ __forceinline__ int nops(const Unit&) { return 0; }
    static constexpr bool PERM = false, AFTER_DRAIN = false, HAS_PRE = false, ROWPERM = false, HAS_PF = false, ZEROS_ACC = false; static constexpr int NST = 32;
    const float* base; float* out; const float* gate; int b0;
    __device__ __forceinline__ void operator()(const f32x4 (&acc)[2][2][4][2], const Unit& u, int wr, int wc, int fr, int fq) const {
        const int row0 = u.pm * BM + wr * 64 + fr, col0 = u.pn * BM + wc * 32 + 4 * fq;
        const float* gp = gate + (size_t)(b0 + ((u.pm * BM) >> 13)) * 6144 + col0;
        f32x4 gv[2][2];
#pragma unroll
        for (int bj = 0; bj < 2; ++bj)
#pragma unroll
            for (int n = 0; n < 2; ++n) gv[bj][n] = *(const f32x4*)(gp + bj * HALF + n * 16);
#pragma unroll
        for (int ai = 0; ai < 2; ++ai)
#pragma unroll
            for (int m = 0; m < 4; ++m) { const size_t off = (size_t)(row0 + ai * HALF + m * 16) * 1024 + col0;
#pragma unroll
                for (int bj = 0; bj < 2; ++bj)
#pragma unroll
                    for (int n = 0; n < 2; ++n) { const f32x4 bs = *(const f32x4*)(base + off + bj * HALF + n * 16);
                        *(f32x4*)(out + off + bj * HALF + n * 16) = bs + gv[bj][n] * acc[ai][bj][m][n]; }
                if ((m & (RES_GROUP - 1)) == RES_GROUP - 1) asm volatile("" ::: "memory"); }
    }
};
#ifndef PG8_RELAX
#define PG8_RELAX 1
#endif
#ifndef PG8_ALIGN_LOOP
#define PG8_ALIGN_LOOP 1
#endif
template <class Epi, class Sched, bool ALIGN_EPI = false, bool SP2 = false>
__device__ __forceinline__ void gemm_phase(PG8_LAS unsigned char* lds, const Gemm g, const Sched& S, Epi E) {
    int tid_ = threadIdx.x; asm volatile("" : "+v"(tid_));
    const int tid = tid_, wid = __builtin_amdgcn_readfirstlane(tid >> 6), lane = tid & 63, wr = wid >> 2, wc = wid & 3, fr = lane & 15, fq = lane >> 4;
    const int K = g.K, nt = g.ntx ? g.ntx : K / BK;
    unsigned voffA[2], voffB[2];
#pragma unroll
    for (int i = 0; i < 2; ++i) { int R, C; stage_rc(tid * 16 + i * 8192, R, C); const int Rb = Epi::PERM ? ((R & ~31) + perm32(R & 31)) : R;
        const int Ra = Epi::ROWPERM ? ((R >> 6) * 128 + 4 * (R & 15) + ((R >> 4) & 3)) : R;
        voffA[i] = (unsigned)(Ra * K + C) * 2u; voffB[i] = (unsigned)(Rb * K + C) * 2u; }
    const size_t kstep = (size_t)(BK * 2);
    const size_t hstep = (size_t)HALF * K * 2;
    const size_t hstepA = Epi::ROWPERM ? hstep / 2 : hstep;
    const size_t tstep = 2 * hstep;
    const unsigned ldsw = (unsigned)wid * 1024u;
    const int aoff = lds_byte(wr * 64 + fr, fq * 8), boff = lds_byte(wc * 32 + fr, fq * 8);
#define PG8_SA(b, h) (((b) * 2 + (h)) * HTB)
#define PG8_SB(b, h) ((4 + (b) * 2 + (h)) * HTB)
#ifndef PG8_AUXA
#define PG8_AUXA 0
#endif
#ifndef PG8_AUXB
#define PG8_AUXB 0
#endif
#define PG8_STAGEX(bufoff, gbase, voff, aux) do { _Pragma("unroll") for (int _i = 0; _i < 2; ++_i) \
        __builtin_amdgcn_global_load_lds((const unsigned*)((const char*)(gbase) + (voff)[_i]), (PG8_LAS unsigned*)(lds + (bufoff) + ldsw + _i * 8192), 16, 0, aux); } while (0)
#define PG8_STAGEA(bufoff, gbase, voff) PG8_STAGEX(bufoff, gbase, voff, PG8_AUXA)
#define PG8_STAGEB(bufoff, gbase, voff) PG8_STAGEX(bufoff, gbase, voff, PG8_AUXB)
#define PG8_LDA(dst, b, h) do { _Pragma("unroll") for (int m = 0; m < 4; ++m) _Pragma("unroll") for (int k = 0; k < 2; ++k) dst[m][k] = *(const PG8_LAS bf16x8*)(lds + PG8_SA(b, h) + aoff + m * 2048 + k * 1024); } while (0)
#define PG8_LDB(dst, b, h) do { _Pragma("unroll") for (int n = 0; n < 2; ++n) _Pragma("unroll") for (int k = 0; k < 2; ++k) dst[n][k] = *(const PG8_LAS bf16x8*)(lds + PG8_SB(b, h) + boff + n * 2048 + k * 1024); } while (0)
#define PG8_MMA(ai, bj, At, Bt) do { __builtin_amdgcn_s_setprio(1); _Pragma("unroll") for (int m = 0; m < 4; ++m) _Pragma("unroll") for (int n = 0; n < 2; ++n) _Pragma("unroll") for (int k = 0; k < 2; ++k) \
        acc[ai][bj][m][n] = __builtin_amdgcn_mfma_f32_16x16x32_bf16(Bt[n][k], At[m][k], acc[ai][bj][m][n], 0, 0, 0); __builtin_amdgcn_s_setprio(0); } while (0)
#define PG8_WAIT_V(n) asm volatile("s_waitcnt vmcnt(" #n ")" ::: "memory")
#define PG8_WAIT_V8X asm volatile("s_cmp_eq_u32 %0, 0\n\ts_cbranch_scc1 .Lw8_%=\n\ts_cmp_eq_u32 %0, 8\n\ts_cbranch_scc1 .Lw16_%=\n\ts_cmp_eq_u32 %0, 16\n\ts_cbranch_scc1 .Lw24_%=\n\ts_waitcnt vmcnt(32)\n\ts_branch .Lwe_%=\n" \
        ".Lw8_%=:\n\ts_waitcnt vmcnt(8)\n\ts_branch .Lwe_%=\n.Lw16_%=:\n\ts_waitcnt vmcnt(16)\n\ts_branch .Lwe_%=\n.Lw24_%=:\n\ts_waitcnt vmcnt(24)\n.Lwe_%=:" :: "s"(rx) : "memory", "scc")
#define PG8_WAIT_L(n) asm volatile("s_waitcnt lgkmcnt(" #n ")" ::: "memory")
#define PG8_BAR __builtin_amdgcn_s_barrier()
#define PG8_SCHED __builtin_amdgcn_sched_barrier(0)
    Unit cur, nxt; int ui = 0, xprev = 0;
    if (!S.next(0, cur)) return;
    f32x4 acc[2][2][4][2];
#pragma unroll
    for (int a = 0; a < 2; ++a)
#pragma unroll
        for (int b = 0; b < 2; ++b)
#pragma unroll
            for (int m = 0; m < 4; ++m)
#pragma unroll
                for (int n = 0; n < 2; ++n) acc[a][b][m][n] = (f32x4){0.f, 0.f, 0.f, 0.f};
    bf16x8 At[4][2], B0[2][2], B1[2][2];
    const char* cA = (const char*)g.A + (size_t)cur.pm * tstep; const char* cB = (const char*)g.Bt + (size_t)cur.pn * tstep;
    S.a_ready(cur);
    if constexpr (Epi::HAS_PRE) E.pre(lds + STAGE_BYTES, cur, 0, tid);
    if constexpr (SP2) {
        PG8_STAGEB(PG8_SB(0, 0), cB, voffB); PG8_STAGEB(PG8_SB(0, 1), cB + hstep, voffB); PG8_STAGEA(PG8_SA(0, 0), cA, voffA); PG8_STAGEA(PG8_SA(0, 1), cA + hstepA, voffA);
        if (wr == 1) PG8_BAR;
        PG8_WAIT_V(2); PG8_BAR;
        PG8_STAGEB(PG8_SB(1, 0), cB + kstep, voffB); PG8_STAGEA(PG8_SA(1, 0), cA + kstep, voffA); PG8_STAGEB(PG8_SB(1, 1), cB + hstep + kstep, voffB);
        PG8_WAIT_V(6); PG8_BAR;
    } else {
        PG8_STAGEB(PG8_SB(0, 0), cB, voffB); PG8_STAGEA(PG8_SA(0, 0), cA, voffA); PG8_STAGEB(PG8_SB(0, 1), cB + hstep, voffB); PG8_STAGEA(PG8_SA(0, 1), cA + hstepA, voffA);
        if (wr == 1) PG8_BAR;
        PG8_WAIT_V(4); PG8_BAR;
        PG8_STAGEB(PG8_SB(1, 0), cB + kstep, voffB); PG8_STAGEA(PG8_SA(1, 0), cA + kstep, voffA); PG8_STAGEB(PG8_SB(1, 1), cB + hstep + kstep, voffB);
        PG8_WAIT_V(6); PG8_BAR;
    }
    for (;;) {
        const bool has_next = S.next(ui + 1, nxt);
        const char* nA = has_next ? (const char*)g.A + (size_t)nxt.pm * tstep : cA; const char* nB = has_next ? (const char*)g.Bt + (size_t)nxt.pn * tstep : cB;
#if PG8_ALIGN_LOOP
        asm volatile(".p2align 8");
#endif
        int rx = __builtin_amdgcn_readfirstlane((PG8_RELAX && ui > 0) ? xprev : 0); asm volatile("" : "+s"(rx));
        for (int t = 0; t < nt; t += 2) {
            const bool last = (t == nt - 2);
            const char* a1 = cA + (size_t)(t + 1) * kstep;
            const char* a2 = last ? nA : cA + (size_t)(t + 2) * kstep; const char* b2 = last ? nB : cB + (size_t)(t + 2) * kstep;
            const char* a3 = a2 + kstep; const char* b3 = b2 + kstep;
            if (last && has_next) S.a_ready(nxt);
            if constexpr (Epi::HAS_PF) { if (last) E.prefetch(cur, wc, fq); }
            if constexpr (SP2) {
            PG8_LDB(B0, 0, 0); PG8_LDB(B1, 0, 1); PG8_SCHED; PG8_LDA(At, 0, 0); PG8_STAGEA(PG8_SA(1, 1), a1 + hstepA, voffA);
            PG8_WAIT_V8X; PG8_WAIT_L(0); PG8_BAR; PG8_MMA(0, 0, At, B0); PG8_MMA(0, 1, At, B1); PG8_BAR; PG8_SCHED;
            PG8_LDA(At, 0, 1); PG8_STAGEB(PG8_SB(0, 0), b2, voffB); PG8_STAGEB(PG8_SB(0, 1), b2 + hstep, voffB); PG8_STAGEA(PG8_SA(0, 0), a2, voffA);
            PG8_WAIT_V8X; PG8_WAIT_L(0); PG8_BAR; PG8_MMA(1, 0, At, B0); PG8_MMA(1, 1, At, B1); PG8_BAR; PG8_SCHED;
            asm volatile("s_mov_b32 %0, 0" : "=s"(rx));
            PG8_LDB(B0, 1, 0); PG8_LDB(B1, 1, 1); PG8_SCHED; PG8_LDA(At, 1, 0); PG8_STAGEA(PG8_SA(0, 1), a2 + hstepA, voffA);
            PG8_WAIT_V(8); PG8_WAIT_L(0); PG8_BAR; PG8_MMA(0, 0, At, B0); PG8_MMA(0, 1, At, B1); PG8_BAR; PG8_SCHED;
            PG8_LDA(At, 1, 1); PG8_STAGEB(PG8_SB(1, 0), b3, voffB); PG8_STAGEB(PG8_SB(1, 1), b3 + hstep, voffB); PG8_STAGEA(PG8_SA(1, 0), a3, voffA);
            PG8_WAIT_V(8); PG8_WAIT_L(0); PG8_BAR; PG8_MMA(1, 0, At, B0); PG8_MMA(1, 1, At, B1); PG8_BAR; PG8_SCHED;
            } else {
            PG8_LDB(B0, 0, 0); PG8_SCHED; PG8_LDA(At, 0, 0); PG8_STAGEA(PG8_SA(1, 1), a1 + hstepA, voffA);
            PG8_WAIT_L(8); PG8_BAR; PG8_WAIT_L(0); PG8_MMA(0, 0, At, B0); PG8_BAR; PG8_SCHED;
            PG8_LDB(B1, 0, 1); PG8_STAGEB(PG8_SB(0, 0), b2, voffB);
            PG8_BAR; PG8_WAIT_L(0); PG8_MMA(0, 1, At, B1); PG8_BAR;
            PG8_LDA(At, 0, 1); PG8_STAGEA(PG8_SA(0, 0), a2, voffA);
            PG8_BAR; PG8_WAIT_L(0); PG8_MMA(1, 0, At, B0); PG8_BAR; PG8_SCHED;
            PG8_STAGEB(PG8_SB(0, 1), b2 + hstep, voffB);
            PG8_WAIT_V(6); PG8_BAR; PG8_MMA(1, 1, At, B1); PG8_BAR;
            PG8_LDB(B0, 1, 0); PG8_SCHED; PG8_LDA(At, 1, 0); PG8_STAGEA(PG8_SA(0, 1), a2 + hstepA, voffA);
            PG8_WAIT_L(8); PG8_BAR; PG8_WAIT_L(0); PG8_MMA(0, 0, At, B0); PG8_BAR; PG8_SCHED;
            PG8_LDB(B1, 1, 1); PG8_STAGEB(PG8_SB(1, 0), b3, voffB);
            PG8_BAR; PG8_WAIT_L(0); PG8_MMA(0, 1, At, B1); PG8_BAR;
            PG8_LDA(At, 1, 1); PG8_STAGEA(PG8_SA(1, 0), a3, voffA);
            PG8_BAR; PG8_WAIT_L(0); PG8_MMA(1, 0, At, B0); PG8_BAR; PG8_SCHED;
            PG8_STAGEB(PG8_SB(1, 1), b3 + hstep, voffB);
            PG8_WAIT_V(6); PG8_BAR; PG8_MMA(1, 1, At, B1); PG8_BAR;
            }
        }
        if constexpr (ALIGN_EPI) { if (wr == 0) PG8_BAR; }
        if constexpr (Epi::HAS_PRE) { if (has_next) E.pre(lds + STAGE_BYTES, nxt, (ui + 1) & 1, tid);
            E.run(acc, cur, wr, wc, fr, fq, lds + STAGE_BYTES + (ui & 1) * 4096); S.done(cur); }
        else if constexpr (!Epi::AFTER_DRAIN) { E(acc, cur, wr, wc, fr, fq); S.done(cur); }
        if (!has_next) break;
        if constexpr (!Epi::ZEROS_ACC)
#pragma unroll
        for (int a = 0; a < 2; ++a)
#pragma unroll
            for (int b = 0; b < 2; ++b)
#pragma unroll
                for (int m = 0; m < 4; ++m)
#pragma unroll
                    for (int n = 0; n < 2; ++n) acc[a][b][m][n] = (f32x4){0.f, 0.f, 0.f, 0.f};
        xprev = Epi::nops(cur); cur = nxt; cA = nA; cB = nB; ++ui;
        if constexpr (ALIGN_EPI) { if (wr == 1) PG8_BAR; }
    }
    PG8_WAIT_V(0);
    if constexpr (!ALIGN_EPI) { if (wr == 0) PG8_BAR; }
    PG8_BAR;
    if constexpr (Epi::AFTER_DRAIN) { E.fused(acc, cur, wr, wc, fr, fq, lds, wid, lane); S.done(cur); }
#undef PG8_SA
#undef PG8_SB
#undef PG8_STAGEX
#undef PG8_STAGEA
#undef PG8_STAGEB
#undef PG8_LDA
#undef PG8_LDB
#undef PG8_MMA
#undef PG8_WAIT_V
#undef PG8_WAIT_L
#undef PG8_WAIT_V8X
#undef PG8_BAR
#undef PG8_SCHED
}
}
#ifndef PG8_SP2
#define PG8_SP2 true
#endif
#ifndef PG8_ALIGN
#define PG8_ALIGN true
#endif
constexpr int NWAVES = 8;
#ifndef MK_PER_PHASE
#define MK_PER_PHASE 0
#endif

constexpr int D = 1024, SEQ = 8192, NSEQ = 12, SLAB_SEQ = 4, NSLAB = 3, MS = SLAB_SEQ * SEQ;
constexpr int NIN = 5632, NUP = 5632, DFF = 2816;
constexpr int NPJ = 4608;
constexpr int COL_Q = 0, COL_K = 512, COL_V = 1024, COL_A = 2048, COL_P = 3072, COL_B = 3584;
using pg8::pj_tiled; using pg8::pj_pitch; using pg8::pj_blk;
constexpr int NUNIT = SLAB_SEQ * 64 * 8;
constexpr float EPS = 1e-6f;
constexpr int PH_PER_SLAB = 11, NPHASE = 1 + NSLAB * PH_PER_SLAB;

constexpr size_t MiB = 1u << 20;
constexpr size_t WS_CTL = 0, CTL_ZERO_BYTES = 1 * MiB;
constexpr size_t WS_MOD = 1 * MiB;
constexpr size_t WS_DEC = 1 * MiB + 512 * 1024;
constexpr size_t WS_COS = 2 * MiB, WS_SIN = 3 * MiB;
constexpr size_t WS_WIN = 4 * MiB;
constexpr size_t WS_WOUT = 16 * MiB;
constexpr size_t WS_WUP = 18 * MiB;
constexpr size_t WS_WDOWN = 30 * MiB;
constexpr size_t WS_WPOOL = 36 * MiB;
constexpr size_t WS_H = 64 * MiB;
constexpr size_t WS_MERGED = 128 * MiB;
constexpr size_t WS_PROJ = 192 * MiB;
constexpr size_t WS_G = 544 * MiB;
constexpr size_t WS_LST = 720 * MiB;
constexpr size_t WS_BB = 784 * MiB;
constexpr size_t WS_SST = 848 * MiB;
constexpr size_t WS_END = 912 * MiB;
constexpr int CW_TMO = 0, CW_CODE = 1, CW_BAR = 4096;

constexpr int RING_OFF = 0, RING_BYTES = 131072;
constexpr int LDS_BYTES = 163840;
constexpr int LDSCTL_OFF = LDS_BYTES - 512, MISC_OFF = LDSCTL_OFF + 320;

#define GAS __attribute__((address_space(1)))
#define LAS __attribute__((address_space(3)))
typedef unsigned short bf16;
typedef unsigned v4u __attribute__((ext_vector_type(4)));
typedef unsigned v2u __attribute__((ext_vector_type(2)));
typedef float f32x4 __attribute__((ext_vector_type(4)));
typedef short bf16x8 __attribute__((ext_vector_type(8)));
typedef short s16x4 __attribute__((ext_vector_type(4)));
typedef GAS unsigned gu32;
#define RLX_AGENT __ATOMIC_RELAXED, __HIP_MEMORY_SCOPE_AGENT
#define LDS_WAIT() asm volatile("s_waitcnt lgkmcnt(0)" ::: "memory")
#define VM_WAIT() asm volatile("s_waitcnt vmcnt(0)" ::: "memory")
__device__ __forceinline__ unsigned f2bf(float f) { unsigned u = __builtin_bit_cast(unsigned, f); return (u + 0x7fffu + ((u >> 16) & 1u)) >> 16; }
typedef float f32x2_ __attribute__((ext_vector_type(2)));
typedef __bf16 bf16x2_ __attribute__((ext_vector_type(2)));
__device__ __forceinline__ unsigned pk2(float lo, float hi) { const bf16x2_ r = __builtin_convertvector((f32x2_){lo, hi}, bf16x2_); return __builtin_bit_cast(unsigned, r); }
__device__ __forceinline__ float bf2f(unsigned short b) { return __builtin_bit_cast(float, ((unsigned)b) << 16); }
__device__ __forceinline__ float bflo(unsigned w) { return __builtin_bit_cast(float, w << 16); }
__device__ __forceinline__ float bfhi(unsigned w) { return __builtin_bit_cast(float, w & 0xffff0000u); }
__device__ __forceinline__ float sigmoidf_(float x) { return 1.0f / (1.0f + __expf(-x)); }
__device__ __forceinline__ int launder_v(int x) { asm volatile("" : "+v"(x)); return x; }
__device__ __forceinline__ int launder_s(int x) { asm volatile("" : "+s"(x)); return x; }
#define XB_TMO      128
#define XB_XCNT(j)  (256  + 64 * (j))
#define XB_XSUB(j)  (1280 + 64 * (j))
#define XB_XGEN(j)  (2304 + 64 * (j))
#define XB_TOP      3328
#define XB_TOPGEN   3392
#define XCD_BAR_WORDS 3456
#define XB_SPIN_CAP (1u << 18)

__device__ __forceinline__ unsigned xb_ld(unsigned* p)              { return __hip_atomic_load(p, __ATOMIC_RELAXED, __HIP_MEMORY_SCOPE_AGENT); }
__device__ __forceinline__ unsigned xb_add(unsigned* p, unsigned v) { return __hip_atomic_fetch_add(p, v, __ATOMIC_RELAXED, __HIP_MEMORY_SCOPE_AGENT); }
__device__ __forceinline__ unsigned xb_xcc_id() { return (unsigned)__builtin_amdgcn_s_getreg((3 << 11) | 20) & 0xFu; }
#define XB_SPIN(cond, bar) do { unsigned _sp = 0; while (cond) { __builtin_amdgcn_s_sleep(1); \
    if ((++_sp & 255u) == 0u) { if (xb_ld(&(bar)[XB_TMO])) break; if (_sp > XB_SPIN_CAP) { atomicAdd(&(bar)[XB_TMO], 1u); break; } } } } while (0)

struct XcdBarrier {
    unsigned* bar; unsigned x;
    volatile LAS unsigned* st;
};

__device__ __forceinline__ XcdBarrier xcd_barrier_post(unsigned* bar, volatile LAS unsigned* st) {
    XcdBarrier b; b.bar = bar; b.x = xb_xcc_id(); b.st = st;
    if (threadIdx.x == 0) (void)xb_add(&bar[XB_XCNT(b.x)], 1u);
    return b;
}
__device__ __forceinline__ void xcd_barrier_complete(unsigned* bar, unsigned x, unsigned& nloc, unsigned& nx) {
    const unsigned G = gridDim.x * gridDim.y * gridDim.z;
    unsigned sum, cnt, mine, sp = 0u;
    for (;;) {
        sum = 0u; cnt = 0u; mine = 0u;
#pragma unroll
        for (unsigned j = 0; j < 16; ++j) { const unsigned c = xb_ld(&bar[XB_XCNT(j)]); sum += c; cnt += (c > 0u) ? 1u : 0u; mine = (j == x) ? c : mine; }
        if (sum == G) break;
        __builtin_amdgcn_s_sleep(1);
        if ((++sp & 255u) == 0u) { if (xb_ld(&bar[XB_TMO])) break; if (sp > XB_SPIN_CAP) { atomicAdd(&bar[XB_TMO], 1u); break; } }
    }
    nloc = mine > 0u ? mine : 1u; nx = cnt > 0u ? cnt : 1u;
}

__device__ __forceinline__ void xcd_barrier(const XcdBarrier& b) {
    asm volatile("s_waitcnt vmcnt(0)" ::: "memory");
    __syncthreads();
    if (threadIdx.x == 0) {
        unsigned* bar = b.bar;
        __builtin_amdgcn_s_waitcnt(0);
        unsigned nloc = b.st[0], nx = b.st[1];
        if (nloc == 0u) { xcd_barrier_complete(bar, b.x, nloc, nx); b.st[0] = nloc; b.st[1] = nx; }
        const unsigned old = xb_add(&bar[XB_XSUB(b.x)], 1u);
        const unsigned gen = old / nloc;
        if (old + 1u == (gen + 1u) * nloc) {
            __builtin_amdgcn_fence(__ATOMIC_RELEASE, "agent");
            asm volatile("s_waitcnt vmcnt(0)" ::: "memory");
            const unsigned og = xb_add(&bar[XB_TOP], 1u);
            const unsigned tg = og / nx;
            if (og + 1u == (tg + 1u) * nx) xb_add(&bar[XB_TOPGEN], 1u);
            else XB_SPIN(xb_ld(&bar[XB_TOPGEN]) == tg, bar);
            __builtin_amdgcn_fence(__ATOMIC_ACQUIRE, "agent");
            xb_add(&bar[XB_XGEN(b.x)], 1u);
            asm volatile("s_waitcnt vmcnt(0)" ::: "memory");
        } else {
            XB_SPIN(xb_ld(&bar[XB_XGEN(b.x)]) == gen, bar);
            __builtin_amdgcn_fence(__ATOMIC_ACQUIRE, "agent");
            asm volatile("s_waitcnt vmcnt(0)" ::: "memory");
        }
    }
    __syncthreads();
}
#ifndef NT_STREAM
#define NT_STREAM 0
#endif
struct Args { const float* in[20]; float* out; unsigned char* ws; int ph_lo, ph_hi; };
typedef const __attribute__((address_space(4))) Args* KArgs;
__device__ __forceinline__ KArgs get_args() { KArgs p = (KArgs)__builtin_amdgcn_kernarg_segment_ptr(); asm volatile("" : "+s"(p)); return p; }
struct Frame {
    LAS unsigned char* lds;
    volatile LAS unsigned* MISC;
    int tid, lane, wave;
    int vcu, G;
};
#define WSP(A, T, off) ((T*)((A)->ws + (off)))
enum { I_XP = 0, I_XS, I_CP, I_CS, I_WADA, I_BADA, I_GMIX, I_WIN, I_DECF, I_DECB, I_GNG, I_WPOOL, I_PSCALE, I_WOUT, I_GFFN, I_WUP, I_CONVW, I_CONVB, I_WDOWN, I_GFINAL };

__device__ __forceinline__ float wave_sum(float v) {
#pragma unroll
    for (int o = 1; o < 64; o <<= 1) v += __shfl_xor(v, o);
    return v;
}
__device__ __forceinline__ int dst_row_in(int n) {
    if (n < 1024) { const int d = n & 63, nn = d >> 5, i = (d & 31) >> 2, j = d & 3; return (n & ~63) + 8 * i + 4 * nn + j; }
    if (n < 2048) return n;
    if (n < 3072) { const int j = n - 2048; return 2048 + 256 * (j >> 7) + (j & 127); }
    if (n < 3584) return 4096 + (n - 3072);
    if (n < 4608) { const int j = n - 3584; return 2048 + 256 * (j >> 7) + 128 + (j & 127); }
    return 4608 + (n - 4608);
}
__device__ __forceinline__ int dst_row_up(int n) {
    const int lin = n >= DFF ? 1 : 0, f = n - lin * DFF; return 256 * (f >> 7) + 128 * lin + (f & 127);
}
template <int MODE>
__device__ __forceinline__ void p0_transpose_item(const float* W, int K, int N, bf16* WT, LAS float* scr, int item, int lane) {
    const int nblk = N / 32, kb = item / nblk, nb = item % nblk, k0 = 64 * kb, n0 = 32 * nb;
#pragma unroll 16
    for (int i = 0; i < 32; ++i) { const int kk = 2 * i + (lane >> 5); scr[kk * 33 + (lane & 31)] = W[(size_t)(k0 + kk) * N + n0 + (lane & 31)]; }
    LDS_WAIT(); asm volatile("" ::: "memory");
    const int c = lane & 7;
#pragma unroll
    for (int j = 0; j < 4; ++j) { const int n = (lane >> 3) + 8 * j; const LAS float* s = scr + (8 * c) * 33 + n;
        v4u o; o.x = pk2(s[0 * 33], s[1 * 33]); o.y = pk2(s[2 * 33], s[3 * 33]); o.z = pk2(s[4 * 33], s[5 * 33]); o.w = pk2(s[6 * 33], s[7 * 33]);
        const int nr = n0 + n; const int dr = MODE == 1 ? dst_row_in(nr) : (MODE == 2 ? dst_row_up(nr) : nr);
        *(GAS v4u*)(WT + (size_t)dr * K + k0 + 8 * c) = o; }
    LDS_WAIT(); asm volatile("" ::: "memory");
}
__device__ __forceinline__ float lg2_decay(float x) { return (float)(-log1p(exp(-(double)x)) * 1.4426950408889634); }
__device__ __forceinline__ void p0_prologue(Frame& F) {
    const KArgs A = get_args();
    {
        LAS float* sc = (LAS float*)(F.lds);
        LAS float* red = (LAS float*)(F.lds + 49152);
        for (int i = F.tid; i < NSEQ * D; i += NWAVES * 64) { const int b = i >> 10, k = i & 1023; const float cv = b < 8 ? A->in[I_CP][b * D + k] : A->in[I_CS][(b - 8) * D + k]; sc[i] = cv * sigmoidf_(cv); }
        __syncthreads();
        for (int cg = blockIdx.x; cg < 256; cg += F.G) {
            const int col = F.tid & 31, kr = F.tid >> 5;
            float a[NSEQ];
#pragma unroll
            for (int b = 0; b < NSEQ; ++b) a[b] = 0.f;
            if (col < 24) {
                const float* wp = A->in[I_WADA] + 24 * cg + col;
                for (int k0 = kr; k0 < D; k0 += 16 * 16) {
                    float wv[16];
#pragma unroll
                    for (int j = 0; j < 16; ++j) wv[j] = wp[(size_t)(k0 + 16 * j) * 6144];
#pragma unroll
                    for (int j = 0; j < 16; ++j) {
#pragma unroll
                        for (int b = 0; b < NSEQ; ++b) a[b] += sc[b * D + k0 + 16 * j] * wv[j]; } }
#pragma unroll
                for (int b = 0; b < NSEQ; ++b) red[(kr * NSEQ + b) * 24 + col] = a[b];
            }
            __syncthreads();
            if (F.tid < NSEQ * 24) { const int b = F.tid / 24, cc = F.tid % 24; float s = A->in[I_BADA][24 * cg + cc];
#pragma unroll
                for (int r = 0; r < 16; ++r) s += red[(r * NSEQ + b) * 24 + cc];
                WSP(A, float, WS_MOD)[b * 6144 + 24 * cg + cc] = s; }
            __syncthreads();
        }
    }
    if (blockIdx.x == 0 && F.tid < 16) WSP(A, float, WS_DEC)[F.tid] = lg2_decay(F.tid < 8 ? A->in[I_DECF][F.tid] : A->in[I_DECB][F.tid - 8]);
#if !ROT_FLY
    {
        const int gt = blockIdx.x * (NWAVES * 64) + F.tid, NT = F.G * NWAVES * 64;
        for (int i = gt; i < SEQ * 32; i += NT) { const int pos = i >> 5, fi = i & 31;
            const float invf = (float)exp2(-(double)fi * (13.287712379549449 / 32.0));
            const float ang = (float)pos * invf;
            double rev = (double)ang * 0.15915494309189535; rev -= rint(rev);
            const float r = (float)(rev * 6.283185307179586);
            WSP(A, float, WS_COS)[i] = cosf(r); WSP(A, float, WS_SIN)[i] = sinf(r); }
    }
#endif
    {
        LAS float* scr = (LAS float*)(F.lds + RING_OFF + F.wave * 16384);
        const int gw = F.vcu * NWAVES + F.wave, NGW = F.G * NWAVES;
        constexpr int I_IN = (D / 64) * (NIN / 32), I_OUT = (D / 64) * (D / 32), I_UP = (D / 64) * (NUP / 32), I_DN = (DFF / 64) * (D / 32), I_PL = (128 / 64) * (256 / 32);
        constexpr int NITEMS = I_IN + I_OUT + I_UP + I_DN + 4 * I_PL;
        for (int it = gw; it < NITEMS; it += NGW) {
            int r = it;
            if (r < I_IN) { p0_transpose_item<1>(A->in[I_WIN], D, NIN, WSP(A, bf16, WS_WIN), scr, r, F.lane); continue; } r -= I_IN;
            if (r < I_OUT) { p0_transpose_item<0>(A->in[I_WOUT], D, D, WSP(A, bf16, WS_WOUT), scr, r, F.lane); continue; } r -= I_OUT;
            if (r < I_UP) { p0_transpose_item<2>(A->in[I_WUP], D, NUP, WSP(A, bf16, WS_WUP), scr, r, F.lane); continue; } r -= I_UP;
            if (r < I_DN) { p0_transpose_item<0>(A->in[I_WDOWN], DFF, D, WSP(A, bf16, WS_WDOWN), scr, r, F.lane); continue; } r -= I_DN;
            const int g = r / I_PL; r -= g * I_PL;
            p0_transpose_item<0>(A->in[I_WPOOL] + (size_t)g * 128 * 256, 128, 256, WSP(A, bf16, WS_WPOOL) + (size_t)g * 256 * 128, scr, r, F.lane);
        }
    }
}
template <int ND>
__device__ __forceinline__ void norm_rows_bf16(Frame& F_, const float* xin, bf16* d1, const float* g, const float* scl, const float* shf, int b0, bf16* outp) {
    Frame F = F_; F.lane = launder_v(F_.lane); F.wave = launder_s(F_.wave);
    const int gw = F.vcu * NWAVES + F.wave, NGW = F.G * NWAVES;
    for (int blk = gw; blk < MS / 16; blk += NGW) {
        const int r0 = blk * 16, b = b0 + (r0 >> 13);
        f32x4 ca[4], cb[4];
#pragma unroll
        for (int j = 0; j < 4; ++j) { const int col = 4 * F.lane + 256 * j; const f32x4 gv = *(const GAS f32x4*)(g + col), sv = *(const GAS f32x4*)(scl + (size_t)b * 6144 + col);
            ca[j] = gv * (sv + 1.0f); cb[j] = *(const GAS f32x4*)(shf + (size_t)b * 6144 + col); }
        const GAS f32x4* xr = (const GAS f32x4*)(xin + (size_t)r0 * D) + F.lane;
        GAS v2u* dr = (GAS v2u*)(d1 + (size_t)r0 * D) + F.lane;
        f32x4 v[4], vn[4], vm[4]; v2u e[4], en[4], em[4];
#pragma unroll
        for (int j = 0; j < 4; ++j) { v[j] = __builtin_nontemporal_load(xr + 64 * j); vn[j] = __builtin_nontemporal_load(xr + 256 + 64 * j); if (ND) { e[j] = __builtin_nontemporal_load(dr + 64 * j); en[j] = __builtin_nontemporal_load(dr + 256 + 64 * j); } }
        for (int rr = 0; rr < 16; ++rr) {
            if (rr + 2 < 16) {
#pragma unroll
                for (int j = 0; j < 4; ++j) { vm[j] = __builtin_nontemporal_load(xr + (rr + 2) * 256 + 64 * j); if (ND) em[j] = __builtin_nontemporal_load(dr + (rr + 2) * 256 + 64 * j); } }
            float s2 = 0.f;
#pragma unroll
            for (int j = 0; j < 4; ++j) { if (ND) { v[j] += (f32x4){bflo(e[j].x), bfhi(e[j].x), bflo(e[j].y), bfhi(e[j].y)};
                    v2u xw; xw.x = pk2(v[j].x, v[j].y); xw.y = pk2(v[j].z, v[j].w); __builtin_nontemporal_store(xw, dr + rr * 256 + 64 * j);
                    v[j] = (f32x4){bflo(xw.x), bfhi(xw.x), bflo(xw.y), bfhi(xw.y)}; }
                s2 += (v[j].x * v[j].x + v[j].y * v[j].y) + (v[j].z * v[j].z + v[j].w * v[j].w); }
            const float rstd = __builtin_amdgcn_rsqf(wave_sum(s2) * (1.f / D) + EPS);
            GAS v2u* o8 = (GAS v2u*)(outp + (size_t)(r0 + rr) * D) + F.lane;
#pragma unroll
            for (int j = 0; j < 4; ++j) { const f32x4 y = v[j] * rstd * ca[j] + cb[j]; v2u w; w.x = pk2(y.x, y.y); w.y = pk2(y.z, y.w); if (NT_STREAM & 16) __builtin_nontemporal_store(w, o8 + 64 * j); else o8[64 * j] = w; }
#pragma unroll
            for (int j = 0; j < 4; ++j) { v[j] = vn[j]; vn[j] = vm[j]; if (ND) { e[j] = en[j]; en[j] = em[j]; } }
        }
    }
}
__device__ __forceinline__ void final_norm_rows(Frame& F_, const bf16* x1, const bf16* d2, float* yout, const float* g) {
    Frame F = F_; F.lane = launder_v(F_.lane); F.wave = launder_s(F_.wave);
    const int gw = F.vcu * NWAVES + F.wave, NGW = F.G * NWAVES;
    f32x4 cg[4];
#pragma unroll
    for (int j = 0; j < 4; ++j) cg[j] = *(const GAS f32x4*)(g + 4 * F.lane + 256 * j);
    for (int blk = gw; blk < MS / 16; blk += NGW) {
        const GAS v2u* dr1 = (const GAS v2u*)(x1 + (size_t)(blk * 16) * D) + F.lane;
        const GAS v2u* dr2 = (const GAS v2u*)(d2 + (size_t)(blk * 16) * D) + F.lane;
        GAS f32x4* yr = (GAS f32x4*)(yout + (size_t)(blk * 16) * D) + F.lane;
        v2u e1[4], e1n[4], e1m[4], e2[4], e2n[4], e2m[4];
#pragma unroll
        for (int j = 0; j < 4; ++j) { e1[j] = __builtin_nontemporal_load(dr1 + 64 * j); e2[j] = __builtin_nontemporal_load(dr2 + 64 * j); e1n[j] = __builtin_nontemporal_load(dr1 + 256 + 64 * j); e2n[j] = __builtin_nontemporal_load(dr2 + 256 + 64 * j); }
        for (int rr = 0; rr < 16; ++rr) {
            if (rr + 2 < 16) {
#pragma unroll
                for (int j = 0; j < 4; ++j) { e1m[j] = __builtin_nontemporal_load(dr1 + (rr + 2) * 256 + 64 * j); e2m[j] = __builtin_nontemporal_load(dr2 + (rr + 2) * 256 + 64 * j); } }
            f32x4 v[4]; float s2 = 0.f;
#pragma unroll
            for (int j = 0; j < 4; ++j) { v[j] = (f32x4){bflo(e1[j].x), bfhi(e1[j].x), bflo(e1[j].y), bfhi(e1[j].y)} + (f32x4){bflo(e2[j].x), bfhi(e2[j].x), bflo(e2[j].y), bfhi(e2[j].y)};
                s2 += (v[j].x * v[j].x + v[j].y * v[j].y) + (v[j].z * v[j].z + v[j].w * v[j].w); }
            const float rstd = __builtin_amdgcn_rsqf(wave_sum(s2) * (1.f / D) + EPS);
#pragma unroll
            for (int j = 0; j < 4; ++j) __builtin_nontemporal_store(v[j] * rstd * cg[j], (f32x4*)(yr + rr * 256 + 64 * j));
#pragma unroll
            for (int j = 0; j < 4; ++j) { e1[j] = e1n[j]; e1n[j] = e1m[j]; e2[j] = e2n[j]; e2n[j] = e2m[j]; }
        }
    }
}
constexpr int C1_V = 0, C1_KF = 36864, C1_KB = 36864 + 20480, C1_SCR = 36864 + 2 * 20480;
__device__ __forceinline__ void c1_phase(Frame& F_) {
    const KArgs A = get_args();
    LAS unsigned char* L = F_.lds;
    const int tid0 = launder_v(F_.tid), w = launder_s(F_.wave);
    const bf16* PROJ = WSP(A, bf16, WS_PROJ);
    int u = F_.vcu; if (u >= NUNIT) return;
    v4u sv[4], sk[2];
#define C1_CONSTS(t) const int tid = launder_v(t), lane = tid & 63, g = lane >> 4, q = (lane & 15) >> 2, p = lane & 3, l15 = lane & 15; \
    unsigned offK[2], offV[4]; \
    _Pragma("unroll") for (int i = 0; i < 2; ++i) { const int id = tid + 512 * i, rr = id >> 3, cc = id & 7; offK[i] = (unsigned)(rr * pj_pitch(COL_K, 8, 64) + cc * 8) * 2u; } \
    _Pragma("unroll") for (int i = 0; i < 4; ++i) { const int id = tid + 512 * i, rr = id >> 4, cc = id & 15; offV[i] = (unsigned)(rr * pj_pitch(COL_V, 8, 128) + cc * 8) * 2u; } (void)q; (void)p; (void)l15; (void)g
#define LDG(T, base, off) __builtin_nontemporal_load((const GAS T*)((const GAS char*)(base) + (unsigned)launder_v((int)(off))))
#define C1_LOAD(uu) do { const int sq_ = (uu) >> 9, c_ = ((uu) >> 3) & 63, h_ = (uu) & 7, ch_ = sq_ * 64 + c_; \
        _Pragma("unroll") for (int i = 0; i < 4; ++i) sv[i] = LDG(v4u, PROJ + pj_blk(COL_V, 8, 128, ch_, h_), offV[i]); \
        _Pragma("unroll") for (int i = 0; i < 2; ++i) sk[i] = LDG(v4u, PROJ + pj_blk(COL_K, 8, 64, ch_, h_), offK[i]); } while (0)
#define C1_WRITE(uu) do { const float l2f = WSP(A, float, WS_DEC)[(uu) & 7], l2b = WSP(A, float, WS_DEC)[8 + ((uu) & 7)]; \
        _Pragma("unroll") for (int i = 0; i < 4; ++i) { const int id = tid + 512 * i, rr = id >> 4, cc = id & 15; *(LAS v4u*)(L + C1_V + rr * 288 + cc * 16) = sv[i]; } \
        _Pragma("unroll") for (int i = 0; i < 2; ++i) { const int id = tid + 512 * i, rr = id >> 3, cc = id & 7; const v4u kv = sk[i]; \
            const float wf = __builtin_amdgcn_exp2f(l2f * (float)(127 - rr)), wb = __builtin_amdgcn_exp2f(l2b * (float)rr); v4u kf, kb; \
            kf.x = pk2(bflo(kv.x) * wf, bfhi(kv.x) * wf); kf.y = pk2(bflo(kv.y) * wf, bfhi(kv.y) * wf); kf.z = pk2(bflo(kv.z) * wf, bfhi(kv.z) * wf); kf.w = pk2(bflo(kv.w) * wf, bfhi(kv.w) * wf); \
            kb.x = pk2(bflo(kv.x) * wb, bfhi(kv.x) * wb); kb.y = pk2(bflo(kv.y) * wb, bfhi(kv.y) * wb); kb.z = pk2(bflo(kv.z) * wb, bfhi(kv.z) * wb); kb.w = pk2(bflo(kv.w) * wb, bfhi(kv.w) * wb); \
            *(LAS v4u*)(L + C1_KF + rr * 160 + cc * 16) = kf; *(LAS v4u*)(L + C1_KB + rr * 160 + cc * 16) = kb; } } while (0)
    { C1_CONSTS(tid0); C1_LOAD(u); C1_WRITE(u); }
    __syncthreads();
    for (;;) {
        C1_CONSTS(tid0);
        const int un = u + F_.G; const bool has_next = un < NUNIT;
        if (has_next) C1_LOAD(un);
        asm volatile("" ::: "memory");
        f32x4 af[4], ab[4];
#pragma unroll
        for (int i = 0; i < 4; ++i) { af[i] = (f32x4){0.f, 0.f, 0.f, 0.f}; ab[i] = (f32x4){0.f, 0.f, 0.f, 0.f}; }
#pragma unroll
        for (int kb = 0; kb < 4; ++kb) {
            const int rowa = 32 * kb + 4 * g + q;
            const s16x4 v0 = __builtin_amdgcn_ds_read_tr16_b64_v4i16((LAS s16x4*)(L + C1_V + rowa * 288 + (16 * w + 4 * p) * 2));
            const s16x4 v1 = __builtin_amdgcn_ds_read_tr16_b64_v4i16((LAS s16x4*)(L + C1_V + (rowa + 16) * 288 + (16 * w + 4 * p) * 2));
            const bf16x8 vf = (bf16x8){v0.x, v0.y, v0.z, v0.w, v1.x, v1.y, v1.z, v1.w};
            s16x4 f0[4], f1[4], b0[4], b1[4];
#pragma unroll
            for (int db = 0; db < 4; ++db) {
                f0[db] = __builtin_amdgcn_ds_read_tr16_b64_v4i16((LAS s16x4*)(L + C1_KF + rowa * 160 + (16 * db + 4 * p) * 2));
                f1[db] = __builtin_amdgcn_ds_read_tr16_b64_v4i16((LAS s16x4*)(L + C1_KF + (rowa + 16) * 160 + (16 * db + 4 * p) * 2));
                b0[db] = __builtin_amdgcn_ds_read_tr16_b64_v4i16((LAS s16x4*)(L + C1_KB + rowa * 160 + (16 * db + 4 * p) * 2));
                b1[db] = __builtin_amdgcn_ds_read_tr16_b64_v4i16((LAS s16x4*)(L + C1_KB + (rowa + 16) * 160 + (16 * db + 4 * p) * 2)); }
            __builtin_amdgcn_sched_barrier(0);
#pragma unroll
            for (int db = 0; db < 4; ++db) {
                af[db] = __builtin_amdgcn_mfma_f32_16x16x32_bf16((bf16x8){f0[db].x, f0[db].y, f0[db].z, f0[db].w, f1[db].x, f1[db].y, f1[db].z, f1[db].w}, vf, af[db], 0, 0, 0);
                ab[db] = __builtin_amdgcn_mfma_f32_16x16x32_bf16((bf16x8){b0[db].x, b0[db].y, b0[db].z, b0[db].w, b1[db].x, b1[db].y, b1[db].z, b1[db].w}, vf, ab[db], 0, 0, 0);
            }
        }
        { LAS unsigned char* S = L + C1_SCR + w * 4096;
#pragma unroll
          for (int db = 0; db < 4; ++db) { v2u o; o.x = pk2(af[db].x, af[db].y); o.y = pk2(af[db].z, af[db].w);
              const int ch = (2 * db + (g >> 1)) ^ (l15 & 7), sub = (g & 1) * 8;
              *(LAS v2u*)(S + l15 * 128 + ch * 16 + sub) = o;
              o.x = pk2(ab[db].x, ab[db].y); o.y = pk2(ab[db].z, ab[db].w); *(LAS v2u*)(S + 2048 + l15 * 128 + ch * 16 + sub) = o; }
          bf16* lo = WSP(A, bf16, WS_LST) + (size_t)u * (2 * 128 * 64) + (16 * w) * 64;
#pragma unroll
          for (int i = 0; i < 4; ++i) { const int id = lane + 64 * i, dir = id >> 7, rr = (id >> 3) & 15, cc = id & 7;
              const v4u v = *(const LAS v4u*)(S + dir * 2048 + rr * 128 + ((cc ^ (rr & 7)) * 16));
              if (NT_STREAM & 1) __builtin_nontemporal_store(v, (GAS v4u*)(lo + dir * (128 * 64) + rr * 64 + cc * 8)); else *(GAS v4u*)(lo + dir * (128 * 64) + rr * 64 + cc * 8) = v; } }
        __syncthreads();
        if (!has_next) break;
        C1_WRITE(un); u = un;
        __syncthreads();
    }
#undef C1_CONSTS
#undef C1_LOAD
#undef C1_WRITE
#undef LDG
}
__device__ __forceinline__ void c2_scan(Frame& F_) {
    const KArgs A = get_args();
    Frame F = F_; F.tid = launder_v(F_.tid);
    const int NT = F.G * NWAVES * 64;
    for (int gid = blockIdx.x * (NWAVES * 64) + F.tid; gid < SLAB_SEQ * 8 * 2 * 2048; gid += NT) {
        const int e4 = gid & 2047, dir = (gid >> 11) & 1, h = (gid >> 12) & 7, sq = gid >> 15;
        const float Gd = __builtin_amdgcn_exp2f(128.0f * WSP(A, float, WS_DEC)[dir * 8 + h]);
        const size_t ustride = (size_t)8 * (2 * 128 * 64);
        const size_t base = ((size_t)(sq * 512 + h) * 2 + dir) * (128 * 64) + (size_t)e4 * 4;
        const bf16* lp = WSP(A, bf16, WS_LST) + base; bf16* sp = WSP(A, bf16, WS_SST) + base;
        f32x4 S = (f32x4){0.f, 0.f, 0.f, 0.f};
        for (int i0 = 0; i0 < 64; i0 += 16) {
            v2u l[16];
#pragma unroll
            for (int j = 0; j < 16; ++j) { const int c = dir ? 63 - (i0 + j) : i0 + j; l[j] = __builtin_nontemporal_load((const GAS v2u*)(lp + c * ustride)); }
#pragma unroll
            for (int j = 0; j < 16; ++j) { const int c = dir ? 63 - (i0 + j) : i0 + j;
                v2u o; o.x = pk2(S.x, S.y); o.y = pk2(S.z, S.w); if (NT_STREAM & 2) __builtin_nontemporal_store(o, (GAS v2u*)(sp + c * ustride)); else *(GAS v2u*)(sp + c * ustride) = o;
                S = S * Gd + (f32x4){bflo(l[j].x), bfhi(l[j].x), bflo(l[j].y), bfhi(l[j].y)}; }
        }
    }
}
constexpr int PL_WP = 0, PL_WAVE = 65536;
__device__ __forceinline__ void pool_units(Frame& F_) {
    const KArgs A = get_args();
    const int tid = launder_v(F_.tid), lane = tid & 63, w = launder_s(F_.wave);
    LAS unsigned char* L = F_.lds;
    const int g = lane >> 4, l15 = lane & 15;
    const bf16* PROJ = WSP(A, bf16, WS_PROJ); bf16* BB = WSP(A, bf16, WS_BB);
    const int gi = F_.vcu & 3, nb_gi = (F_.G - gi + 3) >> 2;
    if (F_.G < 4) return;
    { const bf16* wp = WSP(A, bf16, WS_WPOOL) + (size_t)gi * 256 * 128;
#pragma unroll
      for (int i = 0; i < 8; ++i) { const int id = tid + 512 * i, rr = id >> 4, cc = id & 15;
          const v4u wv = *(const GAS v4u*)(wp + rr * 128 + cc * 8); const float ps = A->in[I_PSCALE][gi * 256 + rr];
          v4u o; o.x = pk2(bflo(wv.x) * ps, bfhi(wv.x) * ps); o.y = pk2(bflo(wv.y) * ps, bfhi(wv.y) * ps); o.z = pk2(bflo(wv.z) * ps, bfhi(wv.z) * ps); o.w = pk2(bflo(wv.w) * ps, bfhi(wv.w) * ps);
          *(LAS v4u*)(L + PL_WP + rr * 256 + ((cc ^ (rr & 15)) * 16)) = o; } }
    __syncthreads();
    LAS unsigned char* W = L + PL_WAVE + w * 8192;
    const int half = 1 << gi;
    const int wv0 = (F_.vcu >> 2) * NWAVES + w, wvn = nb_gi * NWAVES;
    v4u st[8];
#define PL_LOAD(uu) do { const int sq_ = (uu) >> 9, rb_ = (uu) & 511; \
        _Pragma("unroll") for (int i = 0; i < 8; ++i) { const int id = lane + 64 * i, rr = id >> 4, cc = id & 15, pos = rb_ * 16 - 8 + rr; \
            st[i] = (v4u){0u, 0u, 0u, 0u}; if (pos >= 0 && pos < SEQ) st[i] = __builtin_nontemporal_load((const GAS v4u*)(PROJ + pj_blk(COL_P, 4, 128, (sq_ * SEQ + pos) >> 7, gi) + (pos & 127) * pj_pitch(COL_P, 4, 128) + cc * 8)); } } while (0)
    int uu = wv0;
    if (uu < SLAB_SEQ * 512) PL_LOAD(uu);
    for (; uu < SLAB_SEQ * 512; uu += wvn) {
        const int sq = uu >> 9, rb = uu & 511, row0 = sq * SEQ + rb * 16;
#pragma unroll
        for (int i = 0; i < 8; ++i) { const int id = lane + 64 * i, rr = id >> 4, cc = id & 15; *(LAS v4u*)(W + rr * 256 + cc * 16) = st[i]; }
        const int un = uu + wvn;
        if (un < SLAB_SEQ * 512) PL_LOAD(un);
        asm volatile("" ::: "memory");
        const LAS unsigned* pr = (const LAS unsigned*)W + lane;
        float s0 = 0.f, s1 = 0.f;
        for (int k = 8 - half; k < 8 + half; ++k) { const unsigned x = pr[k * 64]; s0 += bflo(x); s1 += bfhi(x); }
        unsigned pooled[16];
#pragma unroll
        for (int n = 0; n < 16; ++n) { const int pos = rb * 16 + n; const int lo = pos - half < 0 ? 0 : pos - half, hi = pos + half > SEQ ? SEQ : pos + half;
            const float rc = __builtin_amdgcn_rcpf((float)(hi - lo)); const unsigned x = pr[(n + 8) * 64];
            pooled[n] = pk2(s0 * rc - bflo(x), s1 * rc - bfhi(x));
            const unsigned xa = pr[(n + 8 + half) * 64], xs = pr[(n + 8 - half) * 64]; s0 += bflo(xa) - bflo(xs); s1 += bfhi(xa) - bfhi(xs); }
#pragma unroll
        for (int n = 0; n < 16; ++n) *(LAS unsigned*)(W + n * 256 + (((lane >> 2) ^ n) * 16) + (lane & 3) * 4) = pooled[n];
        f32x4 acc[16];
#pragma unroll
        for (int i = 0; i < 16; ++i) acc[i] = (f32x4){0.f, 0.f, 0.f, 0.f};
#pragma unroll
        for (int kb = 0; kb < 4; ++kb) {
            const bf16x8 a = *(const LAS bf16x8*)(W + l15 * 256 + (((4 * kb + g) ^ l15) * 16));
            for (int h8 = 0; h8 < 2; ++h8) { bf16x8 b[8];
#pragma unroll
                for (int nb = 0; nb < 8; ++nb) b[nb] = *(const LAS bf16x8*)(L + PL_WP + (16 * (8 * h8 + nb) + l15) * 256 + (((4 * kb + g) ^ l15) * 16));
                __builtin_amdgcn_sched_barrier(0);
#pragma unroll
                for (int nb = 0; nb < 8; ++nb) acc[8 * h8 + nb] = __builtin_amdgcn_mfma_f32_16x16x32_bf16(b[nb], a, acc[8 * h8 + nb], 0, 0, 0); }
        }
#pragma unroll
        for (int nb = 0; nb < 16; ++nb) { const f32x4 o = acc[nb];
            v2u ow; ow.x = pk2(o.x, o.y); ow.y = pk2(o.z, o.w); *(LAS v2u*)(W + l15 * 512 + (((2 * nb + (g >> 1)) ^ l15) * 16) + (g & 1) * 8) = ow; }
        bf16* orow = BB + (size_t)row0 * D + gi * 256;
#pragma unroll
        for (int i = 0; i < 8; ++i) { const int id = lane + 64 * i, rr = id >> 5, cc = id & 31;
            const v4u v = *(const LAS v4u*)(W + rr * 512 + ((cc ^ rr) * 16));
            if (NT_STREAM & 4) __builtin_nontemporal_store(v, (GAS v4u*)(orow + (size_t)rr * D + cc * 8)); else *(GAS v4u*)(orow + (size_t)rr * D + cc * 8) = v; }
    }
#undef PL_LOAD
    __syncthreads();
}
constexpr int C3_K = 0, C3_V = 18432, C3_SF = 18432 + 36864, C3_SB = C3_SF + 18432, C3_GAIN = C3_SB + 18432, C3_Y = C3_GAIN + 512, C3_DEC = C3_Y + 128 * 272;
__device__ __forceinline__ float fast_sigmoid(float x) { return __builtin_amdgcn_rcpf(1.0f + __builtin_amdgcn_exp2f(-1.4426950408889634f * x)); }
__device__ __forceinline__ void c3_phase(Frame& F_, int mode) {
    const KArgs A = get_args();
    const int tid0 = launder_v(F_.tid), w = launder_s(F_.wave);
    LAS unsigned char* L = F_.lds;
    const bf16* PROJ = WSP(A, bf16, WS_PROJ); const bf16* SST = WSP(A, bf16, WS_SST); const bf16* BB = WSP(A, bf16, WS_BB); bf16* MERGED = WSP(A, bf16, WS_MERGED);
    int u = F_.vcu; if (u >= NUNIT) return;
    v4u sk[2], sv[4], ssf[2], ssb[2], qn[2], qc[2];
#define C3_CONSTS(t) const int tid = launder_v(t), lane = tid & 63, g = lane >> 4, q = (lane & 15) >> 2, p = lane & 3, l15 = lane & 15, n = 16 * w + l15; \
    unsigned offK[2], offS[2], offV[4]; \
    _Pragma("unroll") for (int i = 0; i < 2; ++i) { const int id = tid + 512 * i, rr = id >> 3, cc = id & 7; offK[i] = (unsigned)(rr * pj_pitch(COL_K, 8, 64) + cc * 8) * 2u; offS[i] = (unsigned)(rr * 64 + cc * 8) * 2u; } \
    _Pragma("unroll") for (int i = 0; i < 4; ++i) { const int id = tid + 512 * i, rr = id >> 4, cc = id & 15; offV[i] = (unsigned)(rr * pj_pitch(COL_V, 8, 128) + cc * 8) * 2u; } \
    const unsigned offQ = (unsigned)(n * pj_pitch(COL_Q, 8, 64) + 8 * g) * 2u, offG = (unsigned)(n * 128 + 4 * g) * 2u, offO = (unsigned)(n * D + 4 * g) * 2u; (void)q; (void)p; (void)offG; (void)offO; (void)offQ
#define LDG(T, base, off) __builtin_nontemporal_load((const GAS T*)((const GAS char*)(base) + (unsigned)launder_v((int)(off))))
#define C3_LOAD(uu) do { const int sq_ = (uu) >> 9, c_ = ((uu) >> 3) & 63, h_ = (uu) & 7, ch_ = sq_ * 64 + c_; \
        const bf16* bk_ = PROJ + pj_blk(COL_K, 8, 64, ch_, h_); const bf16* bv_ = PROJ + pj_blk(COL_V, 8, 128, ch_, h_); const bf16* bq_ = PROJ + pj_blk(COL_Q, 8, 64, ch_, h_); const bf16* bs_ = SST + (size_t)(uu) * (2 * 128 * 64); \
        _Pragma("unroll") for (int i = 0; i < 2; ++i) { sk[i] = LDG(v4u, bk_, offK[i]); ssf[i] = LDG(v4u, bs_, offS[i]); ssb[i] = LDG(v4u, bs_ + 128 * 64, offS[i]); } \
        _Pragma("unroll") for (int i = 0; i < 4; ++i) sv[i] = LDG(v4u, bv_, offV[i]); \
        _Pragma("unroll") for (int kb = 0; kb < 2; ++kb) qn[kb] = LDG(v4u, bq_ + 32 * kb, offQ); } while (0)
#define C3_WRITE() do { \
        _Pragma("unroll") for (int i = 0; i < 2; ++i) { const int id = tid + 512 * i, rr = id >> 3, cc = id & 7; \
            *(LAS v4u*)(L + C3_K + rr * 144 + cc * 16) = sk[i]; *(LAS v4u*)(L + C3_SF + rr * 144 + cc * 16) = ssf[i]; *(LAS v4u*)(L + C3_SB + rr * 144 + cc * 16) = ssb[i]; } \
        _Pragma("unroll") for (int i = 0; i < 4; ++i) { const int id = tid + 512 * i, rr = id >> 4, cc = id & 15; *(LAS v4u*)(L + C3_V + rr * 288 + cc * 16) = sv[i]; } \
        qc[0] = qn[0]; qc[1] = qn[1]; } while (0)
#define C3_DECTAB(hh) do { if (tid < 255) { const int df_ = 127 - tid; const float l2f_ = WSP(A, float, WS_DEC)[(hh)], l2b_ = WSP(A, float, WS_DEC)[8 + (hh)]; \
        ((LAS float*)(L + C3_DEC))[tid] = __builtin_amdgcn_exp2f(df_ >= 0 ? l2f_ * (float)df_ : l2b_ * (float)(-df_)); } } while (0)
    int cur_h = u & 7;
    { C3_CONSTS(tid0);
      C3_LOAD(u);
      if (tid < 128) ((LAS float*)(L + C3_GAIN))[tid] = A->in[I_GNG][cur_h * 128 + tid];
      C3_DECTAB(cur_h);
      C3_WRITE(); }
    __syncthreads();
    for (;;) {
        C3_CONSTS(tid0);
        const int un = u + F_.G; const bool has_next = un < NUNIT;
        const int sq = u >> 9, c = (u >> 3) & 63, h = u & 7, r0 = sq * SEQ + c * 128;
        if (has_next) C3_LOAD(un);
        const bf16* growA = PROJ + pj_blk(COL_A, 8, 128, sq * 64 + c, h); const bf16* growB = PROJ + pj_blk(COL_B, 8, 128, sq * 64 + c, h);
        const bf16* brow = BB + (size_t)r0 * D + h * 128;
        const float l2f = WSP(A, float, WS_DEC)[h], l2b = WSP(A, float, WS_DEC)[8 + h];
        asm volatile("" ::: "memory");
        v4u gga[4], ggb[4], gbb[4];
        const unsigned offG2 = (unsigned)((tid >> 4) * pj_pitch(COL_A, 8, 128) + (tid & 15) * 8) * 2u, offO2 = (unsigned)((tid >> 4) * D + (tid & 15) * 8) * 2u;
        if (!(mode & 1))
#pragma unroll
        for (int j = 0; j < 4; ++j) { gga[j] = LDG(v4u, growA + 32 * j * pj_pitch(COL_A, 8, 128), offG2); ggb[j] = LDG(v4u, growB + 32 * j * pj_pitch(COL_B, 8, 128), offG2); gbb[j] = LDG(v4u, brow + (size_t)32 * j * D, offO2); }
        asm volatile("" ::: "memory");
        f32x4 sc[8];
#pragma unroll
        for (int kb = 0; kb < 2; ++kb) { bf16x8 kf[8];
#pragma unroll
            for (int mb = 0; mb < 8; ++mb) kf[mb] = *(const LAS bf16x8*)(L + C3_K + (16 * mb + l15) * 144 + (32 * kb + 8 * g) * 2);
            __builtin_amdgcn_sched_barrier(0);
#pragma unroll
            for (int mb = 0; mb < 8; ++mb) sc[mb] = __builtin_amdgcn_mfma_f32_16x16x32_bf16(kf[mb], __builtin_bit_cast(bf16x8, qc[kb]), kb == 0 ? (f32x4){0.f, 0.f, 0.f, 0.f} : sc[mb], 0, 0, 0); }
        bf16x8 pf[4];
        const LAS float* decp = (const LAS float*)(L + C3_DEC) + (127 - n + 4 * g);
#pragma unroll
        for (int kb = 0; kb < 4; ++kb) { float v[8];
#pragma unroll
            for (int t = 0; t < 2; ++t)
#pragma unroll
                for (int e = 0; e < 4; ++e) v[4 * t + e] = sc[2 * kb + t][e] * decp[32 * kb + 16 * t + e];
            v4u pw; pw.x = pk2(v[0], v[1]); pw.y = pk2(v[2], v[3]); pw.z = pk2(v[4], v[5]); pw.w = pk2(v[6], v[7]);
            pf[kb] = __builtin_bit_cast(bf16x8, pw); }
        f32x4 ao[8];
#pragma unroll
        for (int i = 0; i < 8; ++i) ao[i] = (f32x4){0.f, 0.f, 0.f, 0.f};
#pragma unroll
        for (int kb = 0; kb < 4; ++kb) { const int rowa = 32 * kb + 4 * g + q;
            s16x4 v0[8], v1[8];
#pragma unroll
            for (int nb = 0; nb < 8; ++nb) {
                v0[nb] = __builtin_amdgcn_ds_read_tr16_b64_v4i16((LAS s16x4*)(L + C3_V + rowa * 288 + (16 * nb + 4 * p) * 2));
                v1[nb] = __builtin_amdgcn_ds_read_tr16_b64_v4i16((LAS s16x4*)(L + C3_V + (rowa + 16) * 288 + (16 * nb + 4 * p) * 2)); }
            __builtin_amdgcn_sched_barrier(0);
#pragma unroll
            for (int nb = 0; nb < 8; ++nb)
                ao[nb] = __builtin_amdgcn_mfma_f32_16x16x32_bf16((bf16x8){v0[nb].x, v0[nb].y, v0[nb].z, v0[nb].w, v1[nb].x, v1[nb].y, v1[nb].z, v1[nb].w}, pf[kb], ao[nb], 0, 0, 0); }
        { const float dqf = __builtin_amdgcn_exp2f(l2f * (float)(n + 1)), dqb = __builtin_amdgcn_exp2f(l2b * (float)(128 - n));
#pragma unroll
          for (int kb = 0; kb < 2; ++kb) { const v4u qv = qc[kb]; v4u qf, qb;
              qf.x = pk2(bflo(qv.x) * dqf, bfhi(qv.x) * dqf); qf.y = pk2(bflo(qv.y) * dqf, bfhi(qv.y) * dqf); qf.z = pk2(bflo(qv.z) * dqf, bfhi(qv.z) * dqf); qf.w = pk2(bflo(qv.w) * dqf, bfhi(qv.w) * dqf);
              qb.x = pk2(bflo(qv.x) * dqb, bfhi(qv.x) * dqb); qb.y = pk2(bflo(qv.y) * dqb, bfhi(qv.y) * dqb); qb.z = pk2(bflo(qv.z) * dqb, bfhi(qv.z) * dqb); qb.w = pk2(bflo(qv.w) * dqb, bfhi(qv.w) * dqb);
              { bf16x8 sf[8];
#pragma unroll
                for (int nb = 0; nb < 8; ++nb) sf[nb] = *(const LAS bf16x8*)(L + C3_SF + (16 * nb + l15) * 144 + (32 * kb + 8 * g) * 2);
                __builtin_amdgcn_sched_barrier(0);
#pragma unroll
                for (int nb = 0; nb < 8; ++nb) ao[nb] = __builtin_amdgcn_mfma_f32_16x16x32_bf16(sf[nb], __builtin_bit_cast(bf16x8, qf), ao[nb], 0, 0, 0); }
              { bf16x8 sb[8];
#pragma unroll
                for (int nb = 0; nb < 8; ++nb) sb[nb] = *(const LAS bf16x8*)(L + C3_SB + (16 * nb + l15) * 144 + (32 * kb + 8 * g) * 2);
                __builtin_amdgcn_sched_barrier(0);
#pragma unroll
                for (int nb = 0; nb < 8; ++nb) ao[nb] = __builtin_amdgcn_mfma_f32_16x16x32_bf16(sb[nb], __builtin_bit_cast(bf16x8, qb), ao[nb], 0, 0, 0); } } }
        typedef float f32x2n __attribute__((ext_vector_type(2)));
        f32x2n a2 = (f32x2n){0.f, 0.f};
#pragma unroll
        for (int nb = 0; nb < 8; ++nb) { a2 += (f32x2n){ao[nb].x, ao[nb].y}; a2 += (f32x2n){ao[nb].z, ao[nb].w}; }
        float s1 = a2.x + a2.y;
        s1 += __shfl_xor(s1, 16); s1 += __shfl_xor(s1, 32);
        const float mu = s1 * (1.f / 128.f);
        f32x2n q2 = (f32x2n){0.f, 0.f};
#pragma unroll
        for (int nb = 0; nb < 8; ++nb) { const f32x2n d0 = (f32x2n){ao[nb].x, ao[nb].y} - mu, d1 = (f32x2n){ao[nb].z, ao[nb].w} - mu; q2 += d0 * d0; q2 += d1 * d1; }
        float s2 = q2.x + q2.y;
        s2 += __shfl_xor(s2, 16); s2 += __shfl_xor(s2, 32);
        const float rstd = __builtin_amdgcn_rsqf(s2 * (1.f / 128.f) + EPS);
#pragma unroll
        for (int nb = 0; nb < 8; ++nb) { const f32x4 gain = *(const LAS f32x4*)(L + C3_GAIN + (16 * nb + 4 * g) * 4); const f32x4 y = (ao[nb] - mu) * rstd * gain;
            v2u yw; yw.x = pk2(y.x, y.y); yw.y = pk2(y.z, y.w); *(LAS v2u*)(L + C3_Y + n * 272 + (16 * nb + 4 * g) * 2) = yw; }
        __syncthreads();
        bf16* orow = MERGED + (size_t)r0 * D + h * 128;
        if (!(mode & 1))
#pragma unroll
        for (int j = 0; j < 4; ++j) {
            const v4u yv = *(const LAS v4u*)(L + C3_Y + ((tid >> 4) + 32 * j) * 272 + (tid & 15) * 16);
            const unsigned yu[4] = {yv.x, yv.y, yv.z, yv.w}, au[4] = {gga[j].x, gga[j].y, gga[j].z, gga[j].w}, bu[4] = {ggb[j].x, ggb[j].y, ggb[j].z, ggb[j].w}, pu[4] = {gbb[j].x, gbb[j].y, gbb[j].z, gbb[j].w};
            unsigned ow[4];
#pragma unroll
            for (int e = 0; e < 4; ++e) ow[e] = pk2(bflo(au[e]) * bflo(yu[e]) + bflo(bu[e]) * bflo(pu[e]), bfhi(au[e]) * bfhi(yu[e]) + bfhi(bu[e]) * bfhi(pu[e]));
            if (NT_STREAM & 8) __builtin_nontemporal_store((v4u){ow[0], ow[1], ow[2], ow[3]}, (GAS v4u*)((GAS char*)(orow + (size_t)32 * j * D) + (unsigned)launder_v((int)offO2))); else *(GAS v4u*)((GAS char*)(orow + (size_t)32 * j * D) + (unsigned)launder_v((int)offO2)) = (v4u){ow[0], ow[1], ow[2], ow[3]};
        }
        if (!has_next) break;
        if ((un & 7) != cur_h) { cur_h = un & 7; if (tid < 128) ((LAS float*)(L + C3_GAIN))[tid] = A->in[I_GNG][cur_h * 128 + tid]; C3_DECTAB(cur_h); }
        C3_WRITE(); u = un;
        __syncthreads();
    }
#undef C3_LOAD
#undef C3_DECTAB
#undef C3_WRITE
#undef LDG
#undef C3_CONSTS
}
__device__ __forceinline__ float gelu_tanh(float x) { const float t = x * (-2.302208198f + -0.10294324f * x * x); return x * __builtin_amdgcn_rcpf(1.0f + __builtin_amdgcn_exp2f(t)); }
__device__ __forceinline__ void conv_gelu_phase(Frame& F_) {
    const KArgs A = get_args();
    Frame F = F_; F.tid = launder_v(F_.tid);
    const int NT = F.G * NWAVES * 64;
    const bf16* UP = WSP(A, bf16, WS_PROJ);
    constexpr int RUN = 8, NTASK = (MS / RUN) * (DFF / 8);
    LAS float* CW = (LAS float*)F.lds;
    for (int i = F.tid; i < 3 * NUP / 4; i += NWAVES * 64) *(LAS f32x4*)(CW + 4 * i) = *(const GAS f32x4*)(A->in[I_CONVW] + 4 * i);
    for (int i = F.tid; i < NUP / 4; i += NWAVES * 64) *(LAS f32x4*)(CW + 3 * NUP + 4 * i) = *(const GAS f32x4*)(A->in[I_CONVB] + 4 * i);
    __syncthreads();
    const v4u z = (v4u){0u, 0u, 0u, 0u};
    v4u ra[RUN + 2], rl[RUN + 2], na[RUN + 2], nl[RUN + 2];
#define CV_LOADROW(dsta, dstl, tk, i) do { const int ck_ = (tk) % (DFF / 8), run_ = (tk) / (DFF / 8), f0_ = ck_ * 8, r0_ = run_ * RUN; \
        const bf16* base_ = UP + (size_t)r0_ * NUP + 256 * (f0_ >> 7) + (f0_ & 127); \
        const bool ok_ = ((i) == 0) ? ((r0_ & (SEQ - 1)) != 0) : (((i) == RUN + 1) ? (((r0_ + RUN) & (SEQ - 1)) != 0) : true); \
        if (ok_) { dsta[i] = *(const GAS v4u*)(base_ + (ptrdiff_t)((i) - 1) * NUP); dstl[i] = *(const GAS v4u*)(base_ + (ptrdiff_t)((i) - 1) * NUP + 128); } else { dsta[i] = z; dstl[i] = z; } } while (0)
    int task = blockIdx.x * (NWAVES * 64) + F.tid;
    if (task < NTASK) {
#pragma unroll
        for (int i = 0; i < RUN + 2; ++i) CV_LOADROW(ra, rl, task, i); }
    for (; task < NTASK; task += NT) {
        const int tn = task + NT; const bool has_next = tn < NTASK;
        const int ck = task % (DFF / 8), run = task / (DFF / 8), f0 = ck * 8, r0 = run * RUN;
        float wa[3][8], wl[3][8], ba[8], bl[8];
#pragma unroll
        for (int j = 0; j < 4; ++j) { const f32x4 a0 = *(const LAS f32x4*)(CW + j * NUP + f0), a1 = *(const LAS f32x4*)(CW + j * NUP + f0 + 4), l0 = *(const LAS f32x4*)(CW + j * NUP + DFF + f0), l1 = *(const LAS f32x4*)(CW + j * NUP + DFF + f0 + 4);
#pragma unroll
            for (int e = 0; e < 4; ++e) { if (j < 3) { wa[j][e] = a0[e]; wa[j][4 + e] = a1[e]; wl[j][e] = l0[e]; wl[j][4 + e] = l1[e]; } else { ba[e] = a0[e]; ba[4 + e] = a1[e]; bl[e] = l0[e]; bl[4 + e] = l1[e]; } } }
#pragma unroll
        for (int rr = 0; rr < RUN; ++rr) {
            const unsigned pau[4] = {ra[rr].x, ra[rr].y, ra[rr].z, ra[rr].w}, plu[4] = {rl[rr].x, rl[rr].y, rl[rr].z, rl[rr].w}, cau[4] = {ra[rr + 1].x, ra[rr + 1].y, ra[rr + 1].z, ra[rr + 1].w}, clu[4] = {rl[rr + 1].x, rl[rr + 1].y, rl[rr + 1].z, rl[rr + 1].w},
                           nau[4] = {ra[rr + 2].x, ra[rr + 2].y, ra[rr + 2].z, ra[rr + 2].w}, nlu[4] = {rl[rr + 2].x, rl[rr + 2].y, rl[rr + 2].z, rl[rr + 2].w};
            unsigned ow[4];
#pragma unroll
            for (int e2 = 0; e2 < 4; ++e2) {
                const float a0 = bflo(pau[e2]) * wa[0][2 * e2] + bflo(cau[e2]) * wa[1][2 * e2] + bflo(nau[e2]) * wa[2][2 * e2] + ba[2 * e2];
                const float a1 = bfhi(pau[e2]) * wa[0][2 * e2 + 1] + bfhi(cau[e2]) * wa[1][2 * e2 + 1] + bfhi(nau[e2]) * wa[2][2 * e2 + 1] + ba[2 * e2 + 1];
                const float l0 = bflo(plu[e2]) * wl[0][2 * e2] + bflo(clu[e2]) * wl[1][2 * e2] + bflo(nlu[e2]) * wl[2][2 * e2] + bl[2 * e2];
                const float l1 = bfhi(plu[e2]) * wl[0][2 * e2 + 1] + bfhi(clu[e2]) * wl[1][2 * e2 + 1] + bfhi(nlu[e2]) * wl[2][2 * e2 + 1] + bl[2 * e2 + 1];
                ow[e2] = pk2(gelu_tanh(a0) * l0, gelu_tanh(a1) * l1); }
            *(GAS v4u*)(WSP(A, bf16, WS_G) + (size_t)(r0 + rr) * DFF + f0) = (v4u){ow[0], ow[1], ow[2], ow[3]};
            if (has_next) CV_LOADROW(na, nl, tn, rr);
            asm volatile("" ::: "memory");
        }
        if (has_next) { CV_LOADROW(na, nl, tn, RUN); CV_LOADROW(na, nl, tn, RUN + 1); }
#pragma unroll
        for (int i = 0; i < RUN + 2; ++i) { ra[i] = na[i]; rl[i] = nl[i]; }
    }
#undef CV_LOADROW
    __syncthreads();
}

__device__ __forceinline__ void conv_fixup_phase(Frame& F_) {
    const KArgs A = get_args();
    const int tid = launder_v(F_.tid);
    const int NT = F_.G * NWAVES * 64;
    const bf16* EDGE = WSP(A, bf16, WS_LST); bf16* Gb = WSP(A, bf16, WS_G);
    const float* cw = A->in[I_CONVW]; const float* cb = A->in[I_CONVB];
    for (int task = blockIdx.x * (NWAVES * 64) + tid; task < (MS / 128) * 2 * (DFF / 8); task += NT) {
        const int ck = task % (DFF / 8), rs = task / (DFF / 8), seg = rs >> 1, bot = rs & 1, f0 = ck * 8;
        const int gc = 256 * (f0 >> 7) + (f0 & 127);
        const int row = seg * 128 + (bot ? 127 : 0);
        const bf16* e0 = EDGE + (size_t)(seg * 4) * NUP + gc;
        const bf16 *pp, *pc, *pn; bool hp = true, hn = true;
        if (!bot) { pc = e0; pn = e0 + NUP; pp = e0 - NUP; hp = (row & (SEQ - 1)) != 0; }
        else { pp = e0 + 2 * NUP; pc = e0 + 3 * NUP; pn = e0 + 4 * NUP; hn = ((row + 1) & (SEQ - 1)) != 0; }
        unsigned ow[4];
        const v4u z4 = (v4u){0u, 0u, 0u, 0u};
        const v4u apv = hp ? *(const GAS v4u*)pp : z4, acv = *(const GAS v4u*)pc, anv = hn ? *(const GAS v4u*)pn : z4;
        const v4u lpv = hp ? *(const GAS v4u*)(pp + 128) : z4, lcv = *(const GAS v4u*)(pc + 128), lnv = hn ? *(const GAS v4u*)(pn + 128) : z4;
#define UNPK4(v, h) ((f32x4){bflo((v)[2 * (h)]), bfhi((v)[2 * (h)]), bflo((v)[2 * (h) + 1]), bfhi((v)[2 * (h) + 1])})
#pragma unroll
        for (int h4 = 0; h4 < 2; ++h4) {
            const f32x4 ap = UNPK4(apv, h4), ac = UNPK4(acv, h4), an = UNPK4(anv, h4);
            const f32x4 lp = UNPK4(lpv, h4), lcur = UNPK4(lcv, h4), ln = UNPK4(lnv, h4);
            const int oa = f0 + 4 * h4, ol = DFF + f0 + 4 * h4;
            const f32x4 a = ap * *(const GAS f32x4*)(cw + oa) + ac * *(const GAS f32x4*)(cw + NUP + oa) + an * *(const GAS f32x4*)(cw + 2 * NUP + oa) + *(const GAS f32x4*)(cb + oa);
            const f32x4 l = lp * *(const GAS f32x4*)(cw + ol) + lcur * *(const GAS f32x4*)(cw + NUP + ol) + ln * *(const GAS f32x4*)(cw + 2 * NUP + ol) + *(const GAS f32x4*)(cb + ol);
            ow[2 * h4] = pk2(gelu_tanh(a[0]) * l[0], gelu_tanh(a[1]) * l[1]); ow[2 * h4 + 1] = pk2(gelu_tanh(a[2]) * l[2], gelu_tanh(a[3]) * l[3]); }
        *(GAS v4u*)(Gb + (size_t)row * DFF + f0) = (v4u){ow[0], ow[1], ow[2], ow[3]};
#undef UNPK4
    }
}
__device__ __forceinline__ void conv_fixup_tile(Frame& F_, int pm) {
    const KArgs A = get_args();
    const int tid = launder_v(F_.tid);
    const bf16* EDGE = WSP(A, bf16, WS_LST); bf16* Gb = WSP(A, bf16, WS_G);
    const float* cw = A->in[I_CONVW]; const float* cb = A->in[I_CONVB];
    for (int task = tid; task < 4 * (DFF / 8); task += NWAVES * 64) {
        const int ck = task % (DFF / 8), rs = task / (DFF / 8), seg = 2 * pm + (rs >> 1), bot = rs & 1, f0 = ck * 8;
        const int gc = 256 * (f0 >> 7) + (f0 & 127);
        const int row = seg * 128 + (bot ? 127 : 0);
        const bf16* e0 = EDGE + (size_t)(seg * 4) * NUP + gc;
        const bf16 *pp, *pc, *pn; bool hp = true, hn = true;
        if (!bot) { pc = e0; pn = e0 + NUP; pp = e0 - NUP; hp = (row & (SEQ - 1)) != 0; }
        else { pp = e0 + 2 * NUP; pc = e0 + 3 * NUP; pn = e0 + 4 * NUP; hn = ((row + 1) & (SEQ - 1)) != 0; }
        unsigned ow[4];
        const v4u z4 = (v4u){0u, 0u, 0u, 0u};
        const v4u apv = hp ? *(const GAS v4u*)pp : z4, acv = *(const GAS v4u*)pc, anv = hn ? *(const GAS v4u*)pn : z4;
        const v4u lpv = hp ? *(const GAS v4u*)(pp + 128) : z4, lcv = *(const GAS v4u*)(pc + 128), lnv = hn ? *(const GAS v4u*)(pn + 128) : z4;
#define UNPK4(v, h) ((f32x4){bflo((v)[2 * (h)]), bfhi((v)[2 * (h)]), bflo((v)[2 * (h) + 1]), bfhi((v)[2 * (h) + 1])})
#pragma unroll
        for (int h4 = 0; h4 < 2; ++h4) {
            const f32x4 ap = UNPK4(apv, h4), ac = UNPK4(acv, h4), an = UNPK4(anv, h4);
            const f32x4 lp = UNPK4(lpv, h4), lcur = UNPK4(lcv, h4), ln = UNPK4(lnv, h4);
            const int oa = f0 + 4 * h4, ol = DFF + f0 + 4 * h4;
            const f32x4 a = ap * *(const GAS f32x4*)(cw + oa) + ac * *(const GAS f32x4*)(cw + NUP + oa) + an * *(const GAS f32x4*)(cw + 2 * NUP + oa) + *(const GAS f32x4*)(cb + oa);
            const f32x4 l = lp * *(const GAS f32x4*)(cw + ol) + lcur * *(const GAS f32x4*)(cw + NUP + ol) + ln * *(const GAS f32x4*)(cw + 2 * NUP + ol) + *(const GAS f32x4*)(cb + ol);
            ow[2 * h4] = pk2(gelu_tanh(a[0]) * l[0], gelu_tanh(a[1]) * l[1]); ow[2 * h4 + 1] = pk2(gelu_tanh(a[2]) * l[2], gelu_tanh(a[3]) * l[3]); }
        *(GAS v4u*)(Gb + (size_t)row * DFF + f0) = (v4u){ow[0], ow[1], ow[2], ow[3]};
#undef UNPK4
    }
}
#ifndef REP_P0
#define REP_P0 1
#endif
#ifndef REP_P1
#define REP_P1 1
#endif
#ifndef REP_P2
#define REP_P2 1
#endif
#ifndef REP_P3
#define REP_P3 1
#endif
#ifndef REP_P4
#define REP_P4 1
#endif
#ifndef REP_P5
#define REP_P5 1
#endif
#ifndef REP_P6
#define REP_P6 1
#endif
#ifndef REP_P7
#define REP_P7 1
#endif
#ifndef REP_P8
#define REP_P8 1
#endif
#ifndef REP_P9
#define REP_P9 1
#endif
#ifndef REP_P10
#define REP_P10 1
#endif
#ifndef REP_P11
#define REP_P11 1
#endif
#ifndef EN_P0
#define EN_P0 1
#endif
#ifndef EN_P1
#define EN_P1 1
#endif
#ifndef EN_P2
#define EN_P2 1
#endif
#ifndef EN_P3
#define EN_P3 1
#endif
#ifndef EN_P4
#define EN_P4 1
#endif
#ifndef EN_P5
#define EN_P5 1
#endif
#ifndef EN_P6
#define EN_P6 1
#endif
#ifndef EN_P7
#define EN_P7 1
#endif
#ifndef EN_P8
#define EN_P8 1
#endif
#ifndef EN_P9
#define EN_P9 1
#endif
#ifndef EN_P10
#define EN_P10 1
#endif
#ifndef EN_P11
#define EN_P11 1
#endif
#ifndef PROBE_ALT
#define PROBE_ALT 0
#endif
#ifndef PROBE_DRY8
#define PROBE_DRY8 0
#endif
#ifndef FOLD_FIXUP
#define FOLD_FIXUP 0
#endif
#ifndef PROBE_NT8
#define PROBE_NT8 0
#endif
#ifndef PROBE_ZERO
#define PROBE_ZERO 0
#endif
#ifndef PROBE_BAR2
#define PROBE_BAR2 0
#endif
#ifndef FUSE_CONV
#define FUSE_CONV 1
#endif
#ifndef PROBE_DRY
#define PROBE_DRY 0
#endif
#ifndef STG_P2
#define STG_P2 0
#endif
#ifndef STG_P6
#define STG_P6 0
#endif
#ifndef STG_P8
#define STG_P8 0
#endif
#ifndef STG_P10
#define STG_P10 0
#endif
__device__ __forceinline__ void stagger(int window_ticks) {
    if (window_ticks <= 0) return;
    const unsigned x = (unsigned)__builtin_amdgcn_s_getreg((3 << 11) | 20) & 7u;
    const unsigned long long wait = ((unsigned long long)x * (unsigned)window_ticks) >> 3, t0 = __builtin_amdgcn_s_memrealtime();
    while (__builtin_amdgcn_s_memrealtime() - t0 < wait) __builtin_amdgcn_s_sleep(16);
}
__device__ __forceinline__ void stagger_blk(int window_ticks) {
    if (window_ticks <= 0) return;
    const unsigned b = __builtin_bitreverse32((unsigned)blockIdx.x) >> 24;
    const unsigned long long wait = ((unsigned long long)b * (unsigned)window_ticks) >> 8, t0 = __builtin_amdgcn_s_memrealtime();
    while (__builtin_amdgcn_s_memrealtime() - t0 < wait) __builtin_amdgcn_s_sleep(16);
}
#ifndef PROBE_C3
#define PROBE_C3 0
#endif
#ifndef STG_P5
#define STG_P5 0
#endif
#ifndef STG_P3
#define STG_P3 0
#endif
__global__ void __launch_bounds__(NWAVES * 64, 2) enc_fwd(Args args) {
    extern __shared__ __attribute__((aligned(16))) unsigned char lds[];
    Frame F;
    F.lds = (LAS unsigned char*)lds;
    F.MISC = (volatile LAS unsigned*)(F.lds + MISC_OFF);
    F.tid = threadIdx.x; F.lane = F.tid & 63; F.wave = __builtin_amdgcn_readfirstlane(F.tid >> 6);
    F.G = gridDim.x; { const int bx = blockIdx.x; F.vcu = (F.G % 8 == 0) ? (bx % 8) * (F.G / 8) + bx / 8 : bx; }
    for (int u = F.tid; u < (LDS_BYTES - LDSCTL_OFF) / 4; u += NWAVES * 64) ((LAS unsigned*)(F.lds + LDSCTL_OFF))[u] = 0u;
    __syncthreads();
    XcdBarrier bar; bar.bar = (unsigned*)(args.ws + WS_CTL) + CW_BAR; bar.x = 0; bar.st = nullptr;
    if (!MK_PER_PHASE) bar = xcd_barrier_post((unsigned*)(args.ws + WS_CTL) + CW_BAR, F.MISC + 8);
#define GRID_BAR() do { if (MK_PER_PHASE) { if (F.tid == 0) __hip_atomic_store((gu32*)bar.bar - CW_BAR + CW_TMO, 0xBADBA0u, RLX_AGENT); } else { xcd_barrier(bar); if (PROBE_BAR2) xcd_barrier(bar); } } while (0)
    const int lo = args.ph_lo, hi = args.ph_hi;
#define IN(k) (lo <= (k) && (k) < hi)
#define BOTH(k) (IN(k) && IN((k) + 1))
#define XS(A, s) ((s) < 2 ? (A)->in[I_XP] + (size_t)(s) * MS * D : (A)->in[I_XS])
#define OUTS(A, s) ((A)->out + (size_t)(s) * MS * D)

    if (EN_P0 && IN(0)) { p0_prologue(F); if (BOTH(0)) GRID_BAR(); }

    for (int s = 0; s < NSLAB; ++s) {
        const int pb = 1 + s * PH_PER_SLAB;
        const int b0 = s * SLAB_SEQ;
        if (EN_P1 && IN(pb + 0) && (s == 0 || MK_PER_PHASE)) { for (int rep_ = 0, nrep_ = launder_s(REP_P1); rep_ < nrep_; ++rep_) { const KArgs A = get_args();
            norm_rows_bf16<0>(F, XS(A, s), (bf16*)nullptr, A->in[I_GMIX], WSP(A, float, WS_MOD) + 1 * D, WSP(A, float, WS_MOD) + 0 * D, b0, WSP(A, bf16, WS_H)); } if (BOTH(pb + 0)) GRID_BAR(); }
        if (EN_P2 && IN(pb + 1)) { for (int rep_ = 0, nrep_ = launder_s(REP_P2); rep_ < nrep_; ++rep_) { const KArgs A = get_args();
            pg8::Gemm g{WSP(A, bf16, WS_H), WSP(A, bf16, WS_WIN), MS, NIN, D}; pg8::StaticOrder S; S.init(MS, NIN, F.G, (int)blockIdx.x); S.zero = (rep_ > 0 ? PROBE_ZERO : 0); S.rot = PG8_ROTPN;
            pg8::EpiProj E{(rep_ > 0 && (PROBE_ZERO || PROBE_ALT)) ? WSP(A, bf16, WS_G) : WSP(A, bf16, WS_PROJ), NPJ, WSP(A, float, WS_COS), WSP(A, float, WS_SIN), (rep_ > 0 ? PROBE_DRY : 0)};
            pg8::gemm_phase<pg8::EpiProj, pg8::StaticOrder, PG8_ALIGN, PG8_SP2>(F.lds + RING_OFF, g, S, E);
            } if (BOTH(pb + 1)) GRID_BAR();
        }
        if (EN_P3 && IN(pb + 2)) { for (int rep_ = 0, nrep_ = launder_s(REP_P3); rep_ < nrep_; ++rep_) { stagger_blk(STG_P3); c1_phase(F); __syncthreads(); pool_units(F); } if (BOTH(pb + 2)) GRID_BAR(); }
        if (EN_P4 && IN(pb + 3)) { for (int rep_ = 0, nrep_ = launder_s(REP_P4); rep_ < nrep_; ++rep_) { c2_scan(F); } if (BOTH(pb + 3)) GRID_BAR(); }
        if (EN_P5 && IN(pb + 4)) { for (int rep_ = 0, nrep_ = launder_s(REP_P5); rep_ < nrep_; ++rep_) { stagger_blk(STG_P5); c3_phase(F, rep_ > 0 ? PROBE_C3 : 0); } if (BOTH(pb + 4)) GRID_BAR(); }
        if (EN_P6 && IN(pb + 5)) { for (int rep_ = 0, nrep_ = launder_s(REP_P6); rep_ < nrep_; ++rep_) { const KArgs A = get_args();
            pg8::Gemm g{WSP(A, bf16, WS_MERGED), WSP(A, bf16, WS_WOUT), MS, D, D}; pg8::StaticOrder S; S.init(MS, D, F.G, (int)blockIdx.x);
            pg8::EpiGateBf16 E{WSP(A, bf16, WS_BB), WSP(A, float, WS_MOD) + 2 * D, b0};
            pg8::gemm_phase<pg8::EpiGateBf16, pg8::StaticOrder, PG8_ALIGN, PG8_SP2>(F.lds + RING_OFF, g, S, E);
            } if (BOTH(pb + 5)) GRID_BAR();
        }
        if (EN_P7 && IN(pb + 6)) { for (int rep_ = 0, nrep_ = launder_s(REP_P7); rep_ < nrep_; ++rep_) { const KArgs A = get_args();
            norm_rows_bf16<1>(F, XS(A, s), WSP(A, bf16, WS_BB), A->in[I_GFFN], WSP(A, float, WS_MOD) + 4 * D, WSP(A, float, WS_MOD) + 3 * D, b0, WSP(A, bf16, WS_H)); } if (BOTH(pb + 6)) GRID_BAR(); }
        if (EN_P8 && IN(pb + 7)) { for (int rep_ = 0, nrep_ = launder_s(REP_P8); rep_ < nrep_; ++rep_) { const KArgs A = get_args();
            pg8::Gemm g{WSP(A, bf16, WS_H), WSP(A, bf16, WS_WUP), MS, NUP, D, (rep_ > 0 ? PROBE_NT8 : 0)}; pg8::StaticOrder S; S.init(MS, NUP, F.G, (int)blockIdx.x);
#if FUSE_CONV
            pg8::EpiConv E{WSP(A, bf16, WS_G), WSP(A, float, WS_LST), A->in[I_CONVW], A->in[I_CONVB], (rep_ > 0 ? PROBE_DRY8 : 0)};
            pg8::gemm_phase<pg8::EpiConv, pg8::StaticOrder, PG8_ALIGN, PG8_SP2>(F.lds + RING_OFF, g, S, E);
#else
            pg8::EpiStoreBf16 E{WSP(A, bf16, WS_PROJ), NUP};
            pg8::gemm_phase<pg8::EpiStoreBf16, pg8::StaticOrder, PG8_ALIGN, PG8_SP2>(F.lds + RING_OFF, g, S, E);
#endif
            } if (BOTH(pb + 7)) GRID_BAR();
        }
        if (EN_P9 && IN(pb + 8) && !(FUSE_CONV && FOLD_FIXUP && !MK_PER_PHASE)) { for (int rep_ = 0, nrep_ = launder_s(REP_P9); rep_ < nrep_; ++rep_) { if (FUSE_CONV) conv_fixup_phase(F); else conv_gelu_phase(F); } if (BOTH(pb + 8)) GRID_BAR(); }
        if (EN_P10 && IN(pb + 9)) { for (int rep_ = 0, nrep_ = launder_s(REP_P10); rep_ < nrep_; ++rep_) { const KArgs A = get_args();
            pg8::Gemm g{WSP(A, bf16, WS_G), WSP(A, bf16, WS_WDOWN), MS, D, DFF}; pg8::StaticOrder S; S.init(MS, D, F.G, (int)blockIdx.x);
            if (FUSE_CONV && FOLD_FIXUP && !MK_PER_PHASE) { pg8::Unit fu; for (int i = 0; S.next(i, fu); ++i) conv_fixup_tile(F, fu.pm); VM_WAIT(); __syncthreads(); }
            pg8::EpiGateBf16 E{WSP(A, bf16, WS_MERGED), WSP(A, float, WS_MOD) + 5 * D, b0};
            pg8::gemm_phase<pg8::EpiGateBf16, pg8::StaticOrder, PG8_ALIGN, PG8_SP2>(F.lds + RING_OFF, g, S, E);
            } if (BOTH(pb + 9)) GRID_BAR();
        }
        if (EN_P11 && IN(pb + 10)) { for (int rep_ = 0, nrep_ = launder_s(REP_P11); rep_ < nrep_; ++rep_) { const KArgs A = get_args(); final_norm_rows(F, WSP(A, bf16, WS_BB), WSP(A, bf16, WS_MERGED), OUTS(A, s), A->in[I_GFINAL]);
            if (!MK_PER_PHASE && s + 1 < NSLAB) norm_rows_bf16<0>(F, XS(A, s + 1), (bf16*)nullptr, A->in[I_GMIX], WSP(A, float, WS_MOD) + 1 * D, WSP(A, float, WS_MOD) + 0 * D, b0 + SLAB_SEQ, WSP(A, bf16, WS_H)); } if (BOTH(pb + 10)) GRID_BAR(); }
    }
#undef IN
#undef BOTH
}

extern "C" void kernel_launch(void* const* d_in, const int* in_sizes, int n_in, void* d_out, int out_size, void* d_ws, size_t ws_size, hipStream_t stream) {
    static int grid = 0;
    if (grid == 0) {
        if (n_in != 20 || out_size != NSEQ * SEQ * D || ws_size < WS_END) { fprintf(stderr, "kernel_launch: unexpected shapes (n_in %d, out %d, ws %zu); nothing launched\n", n_in, out_size, ws_size); grid = -1; return; }
        int dev = 0, cus = 0, per_cu = 0;
        if (hipGetDevice(&dev) != hipSuccess || hipDeviceGetAttribute(&cus, hipDeviceAttributeMultiprocessorCount, dev) != hipSuccess) { grid = -1; return; }
        if (hipFuncSetAttribute((const void*)enc_fwd, hipFuncAttributeMaxDynamicSharedMemorySize, LDS_BYTES) != hipSuccess) { fprintf(stderr, "kernel_launch: hipFuncSetAttribute failed\n"); grid = -1; return; }
        if (hipOccupancyMaxActiveBlocksPerMultiprocessor(&per_cu, (const void*)enc_fwd, NWAVES * 64, LDS_BYTES) != hipSuccess || per_cu < 1) fprintf(stderr, "kernel_launch: occupancy query reports %d\n", per_cu);
        (void)hipGetLastError();
        grid = cus;
    }
    if (grid < 0) return;
    if (hipMemsetAsync((char*)d_ws + WS_CTL, 0, CTL_ZERO_BYTES, stream) != hipSuccess) return;
    Args a{};
    for (int i = 0; i < 20; ++i) a.in[i] = (const float*)d_in[i];
    a.out = (float*)d_out; a.ws = (unsigned char*)d_ws;
#if MK_PER_PHASE
    for (int p = 0; p < NPHASE; ++p) { a.ph_lo = p; a.ph_hi = p + 1; hipLaunchKernelGGL(enc_fwd, dim3(grid), dim3(NWAVES * 64), LDS_BYTES, stream, a); }
#else
    a.ph_lo = 0; a.ph_hi = NPHASE;
    hipLaunchKernelGGL(enc_fwd, dim3(grid), dim3(NWAVES * 64), LDS_BYTES, stream, a);
#endif
}
```
